# Optimizing an MI355X kernel written in HIP

```python
import jax
import jax.numpy as jnp
from jax import lax
import numpy as np

D_MODEL = 2048
BATCH = 1
SEQ = 16384
DEPTH = 4
DEC_BATCH = 16
DEC_SEQ = 64
PAST_LEN = 1024

CHUNK = 64
N_META = 16
Q_BLOCK = 128
N_MIXERS = 2
N_FOX = (DEPTH + 1) // 2
N_RET = DEPTH // 2
DH_FOX = 128
H_FOX = D_MODEL // DH_FOX
DK_RET = 256
H_RET = D_MODEL // DK_RET
DV_RET = 2 * DK_RET
D_VRET = H_RET * DV_RET
D_FF = 4 * D_MODEL
FOX_IN = 4 * D_MODEL + H_FOX
RET_IN = 2 * H_RET * DK_RET + 2 * D_VRET
ROPE_BASE = 10000.0
EPS = 1e-6
NEG_INF = -1e30

kernel_name = "fox_retention_hybrid_stream_step"


def rmsnorm(x, g):
    xf = x.astype(jnp.float32)
    y = xf * lax.rsqrt(jnp.mean(xf * xf, axis=-1, keepdims=True) + EPS)
    return (y * g.astype(jnp.float32)).astype(x.dtype)


def sq_relu_mlp(x, w_up, w_down):
    h = jax.nn.relu(x @ w_up)
    return (h * h) @ w_down


def fox_project(h, w_in, g_q, g_k, b_f):
    B, T, _ = h.shape
    proj = h @ w_in
    q, k, v, gate, f_logit = jnp.split(proj, [D_MODEL, 2 * D_MODEL, 3 * D_MODEL, 4 * D_MODEL], axis=-1)
    q = rmsnorm(q.reshape(B, T, H_FOX, DH_FOX), g_q)
    k = rmsnorm(k.reshape(B, T, H_FOX, DH_FOX), g_k)
    v = v.reshape(B, T, H_FOX, DH_FOX)
    logf = jax.nn.log_sigmoid((f_logit + b_f).astype(jnp.float32))
    return q, k, v, gate, logf


def fox_attend(q, cq, pq, k, v, ck, pk):
    s = jnp.einsum('bqhd,bkhd->bhqk', q, k, preferred_element_type=jnp.float32) * (DH_FOX ** -0.5)
    s = s + (cq.transpose(0, 2, 1)[..., :, None] - ck.transpose(0, 2, 1)[..., None, :])
    s = jnp.where(pk[None, :] <= pq[:, None], s, NEG_INF)
    p = jax.nn.softmax(s, axis=-1)
    return jnp.einsum('bhqk,bkhd->bqhd', p.astype(v.dtype), v)


def fox_output(o, gate, w_o):
    B, T = o.shape[:2]
    return (o.reshape(B, T, D_MODEL) * jax.nn.sigmoid(gate)) @ w_o


def fox_prompt(h, w_in, g_q, g_k, b_f, w_o):
    B, L, _ = h.shape
    q, k, v, gate, logf = fox_project(h, w_in, g_q, g_k, b_f)
    c = jnp.cumsum(logf, axis=1)
    pos = jnp.arange(L)
    o_meta = fox_attend(q[:, :N_META], c[:, :N_META], pos[:N_META], k, v, c, pos)
    n_blocks = (L - N_META) // Q_BLOCK

    def block(i):
        start = N_META + i * Q_BLOCK
        qb = lax.dynamic_slice_in_dim(q, start, Q_BLOCK, axis=1)
        cb = lax.dynamic_slice_in_dim(c, start, Q_BLOCK, axis=1)
        return fox_attend(qb, cb, start + jnp.arange(Q_BLOCK), k, v, c, pos)

    o_real = lax.map(block, jnp.arange(n_blocks))
    o_real = o_real.transpose(1, 0, 2, 3, 4).reshape(B, L - N_META, H_FOX, DH_FOX)
    o = jnp.concatenate([o_meta, o_real], axis=1)
    return fox_output(o, gate, w_o), k, v, logf


def fox_sample(h, k_cache, v_cache, logf_cache, w_in, g_q, g_k, b_f, w_o):
    B, T, _ = h.shape
    P = k_cache.shape[1]
    q, k, v, gate, logf = fox_project(h, w_in, g_q, g_k, b_f)
    k_all = jnp.concatenate([k_cache.astype(k.dtype), k], axis=1)
    v_all = jnp.concatenate([v_cache.astype(v.dtype), v], axis=1)
    c = jnp.cumsum(jnp.concatenate([logf_cache.astype(jnp.float32), logf], axis=1), axis=1)
    pos = jnp.arange(P + T)
    o = fox_attend(q, c[:, P:], pos[P:], k_all, v_all, c, pos)
    return fox_output(o, gate, w_o), k, v, logf


def ret_log_gamma():
    return jnp.log(1.0 - jnp.power(2.0, -5.0 - jnp.arange(H_RET, dtype=jnp.float32)))


def rotary(x, pos):
    half = x.shape[-1] // 2
    inv = jnp.power(ROPE_BASE, -jnp.arange(half, dtype=jnp.float32) / half)
    ang = pos.astype(jnp.float32)[:, None] * inv[None, :]
    cos = jnp.cos(ang)[None, :, None, :]
    sin = jnp.sin(ang)[None, :, None, :]
    xf = x.astype(jnp.float32)
    x1, x2 = xf[..., :half], xf[..., half:]
    return jnp.concatenate([x1 * cos - x2 * sin, x1 * sin + x2 * cos], axis=-1)


def retention_project(h, w_in, pos):
    B, T, _ = h.shape
    proj = h @ w_in
    dqk = H_RET * DK_RET
    q, k, v, g = jnp.split(proj, [dqk, 2 * dqk, 2 * dqk + D_VRET], axis=-1)
    q = rotary(q.reshape(B, T, H_RET, DK_RET), pos)
    k = rotary(k.reshape(B, T, H_RET, DK_RET), pos) * (DK_RET ** -0.5)
    v = v.reshape(B, T, H_RET, DV_RET).astype(jnp.float32)
    return q, k, v, g


def retention_chunk(S, q, k, v, log_gamma):
    T = q.shape[1]
    idx = jnp.arange(T, dtype=jnp.float32)
    diff = idx[:, None] - idx[None, :]
    decay = jnp.where(diff >= 0, jnp.exp(jnp.maximum(diff, 0.0)[None] * log_gamma[:, None, None]), 0.0)
    scores = jnp.einsum('bthd,bshd->bhts', q, k) * decay[None]
    inner = jnp.einsum('bhts,bshv->bthv', scores, v)
    q_decay = jnp.exp((idx + 1.0)[None, :] * log_gamma[:, None])
    cross = jnp.einsum('bthd,bhdv->bthv', q, S) * q_decay.T[None, :, :, None]
    k_decay = jnp.exp((T - 1.0 - idx)[None, :] * log_gamma[:, None])
    S_new = jnp.exp(T * log_gamma)[None, :, None, None] * S + jnp.einsum('bthd,bthv->bhdv', k * k_decay.T[None, :, :, None], v)
    return S_new, inner + cross


def retention_output(o, g, g_norm, w_o):
    B, T = o.shape[:2]
    o = o * lax.rsqrt(jnp.mean(o * o, axis=-1, keepdims=True) + EPS) * g_norm.astype(jnp.float32)
    o = o.reshape(B, T, D_VRET).astype(g.dtype)
    return (jax.nn.silu(g) * o) @ w_o


def retention_prompt(h, w_in, g_norm, w_o):
    B, L, _ = h.shape
    q, k, v, g = retention_project(h, w_in, jnp.arange(L))
    pad = (-L) % CHUNK
    n_chunks = (L + pad) // CHUNK

    def blocks(t):
        t = jnp.pad(t, ((0, 0), (pad, 0), (0, 0), (0, 0)))
        return t.reshape(B, n_chunks, CHUNK, *t.shape[2:]).swapaxes(0, 1)

    log_gamma = ret_log_gamma()

    def step(S, qkv):
        qb, kb, vb = qkv
        return retention_chunk(S, qb, kb, vb, log_gamma)

    S0 = jnp.zeros((B, H_RET, DK_RET, DV_RET), jnp.float32)
    S_fin, o = lax.scan(step, S0, (blocks(q), blocks(k), blocks(v)))
    o = o.swapaxes(0, 1).reshape(B, L + pad, H_RET, DV_RET)[:, pad:]
    return retention_output(o, g, g_norm, w_o), S_fin


def retention_sample(h, S, w_in, g_norm, w_o):
    B, T, _ = h.shape
    pos = N_META + PAST_LEN + jnp.arange(T)
    q, k, v, g = retention_project(h, w_in, pos)
    S_new, o = retention_chunk(S.astype(jnp.float32), q, k, v, ret_log_gamma())
    return retention_output(o, g, g_norm, w_o), S_new


def setup_inputs(seed: int = 0) -> dict:
    key = jax.random.key(seed)
    ks = jax.random.split(key, 20)

    def nrm(k, shape, scale):
        return scale * jax.random.normal(k, shape, jnp.float32)

    return {
        "x_prompt": nrm(ks[0], (BATCH, SEQ, D_MODEL), 1.0),
        "x_sample": nrm(ks[1], (DEC_BATCH, DEC_SEQ, D_MODEL), 1.0),
        "cache_fox_k": nrm(ks[2], (N_FOX, DEC_BATCH, PAST_LEN, H_FOX, DH_FOX), 1.0),
        "cache_fox_v": nrm(ks[3], (N_FOX, DEC_BATCH, PAST_LEN, H_FOX, DH_FOX), 1.0),
        "cache_fox_logf": jax.nn.log_sigmoid(2.5 + jax.random.normal(ks[4], (N_FOX, DEC_BATCH, PAST_LEN, H_FOX), jnp.float32)),
        "state_ret": nrm(ks[5], (N_RET, DEC_BATCH, H_RET, DK_RET, DV_RET), 0.05),
        "meta_tokens": nrm(ks[6], (N_META, D_MODEL), 1.0),
        "norm_mix": 1.0 + nrm(ks[7], (DEPTH, D_MODEL), 0.05),
        "norm_mlp": 1.0 + nrm(ks[8], (DEPTH, D_MODEL), 0.05),
        "norm_final": 1.0 + nrm(ks[9], (D_MODEL,), 0.05),
        "fox_w_in": nrm(ks[10], (N_FOX, D_MODEL, FOX_IN), D_MODEL ** -0.5),
        "fox_g_q": 1.0 + nrm(ks[11], (N_FOX, DH_FOX), 0.05),
        "fox_g_k": 1.0 + nrm(ks[12], (N_FOX, DH_FOX), 0.05),
        "fox_b_f": jax.random.uniform(ks[13], (N_FOX, H_FOX), jnp.float32, 1.0, 4.0),
        "fox_w_o": nrm(ks[14], (N_FOX, D_MODEL, D_MODEL), D_MODEL ** -0.5),
        "ret_w_in": nrm(ks[15], (N_RET, D_MODEL, RET_IN), D_MODEL ** -0.5),
        "ret_g_norm": 1.0 + nrm(ks[16], (N_RET, H_RET, DV_RET), 0.05),
        "ret_w_o": nrm(ks[17], (N_RET, D_VRET, D_MODEL), D_VRET ** -0.5),
        "mlp_w_up": nrm(ks[18], (DEPTH, D_MODEL, D_FF), D_MODEL ** -0.5),
        "mlp_w_down": nrm(ks[19], (DEPTH, D_FF, D_MODEL), D_FF ** -0.5),
    }


def reference(x_prompt, x_sample, cache_fox_k, cache_fox_v, cache_fox_logf, state_ret, meta_tokens,
              norm_mix, norm_mlp, norm_final, fox_w_in, fox_g_q, fox_g_k, fox_b_f, fox_w_o,
              ret_w_in, ret_g_norm, ret_w_o, mlp_w_up, mlp_w_down):
    B = x_prompt.shape[0]
    meta = jnp.broadcast_to(meta_tokens[None].astype(x_prompt.dtype), (B, N_META, D_MODEL))
    hp = jnp.concatenate([meta, x_prompt], axis=1)
    hs = x_sample
    fk_p, fv_p, ff_p, rs_p = [], [], [], []
    fk_s, fv_s, ff_s, rs_s = [], [], [], []
    for i in range(DEPTH):
        j = i // N_MIXERS
        if i % N_MIXERS == 0:
            yp, kp, vp, lp = fox_prompt(rmsnorm(hp, norm_mix[i]), fox_w_in[j], fox_g_q[j], fox_g_k[j], fox_b_f[j], fox_w_o[j])
            ys, kn, vn, ln = fox_sample(rmsnorm(hs, norm_mix[i]), cache_fox_k[j], cache_fox_v[j], cache_fox_logf[j],
                                        fox_w_in[j], fox_g_q[j], fox_g_k[j], fox_b_f[j], fox_w_o[j])
            fk_p.append(kp); fv_p.append(vp); ff_p.append(lp)
            fk_s.append(kn); fv_s.append(vn); ff_s.append(ln)
        else:
            yp, Sp = retention_prompt(rmsnorm(hp, norm_mix[i]), ret_w_in[j], ret_g_norm[j], ret_w_o[j])
            ys, Sn = retention_sample(rmsnorm(hs, norm_mix[i]), state_ret[j], ret_w_in[j], ret_g_norm[j], ret_w_o[j])
            rs_p.append(Sp.astype(state_ret.dtype)); rs_s.append(Sn.astype(state_ret.dtype))
        hp = hp + yp
        hs = hs + ys
        hp = hp + sq_relu_mlp(rmsnorm(hp, norm_mlp[i]), mlp_w_up[i], mlp_w_down[i])
        hs = hs + sq_relu_mlp(rmsnorm(hs, norm_mlp[i]), mlp_w_up[i], mlp_w_down[i])
    y_prompt = rmsnorm(hp, norm_final)[:, N_META:]
    y_sample = rmsnorm(hs, norm_final)
    fox_k_prompt = jnp.stack(fk_p, axis=0)
    fox_v_prompt = jnp.stack(fv_p, axis=0)
    fox_logf_prompt = jnp.stack(ff_p, axis=0)
    ret_state_prompt = jnp.stack(rs_p, axis=0)
    fox_k_sample = jnp.stack(fk_s, axis=0)
    fox_v_sample = jnp.stack(fv_s, axis=0)
    fox_logf_sample = jnp.stack(ff_s, axis=0)
    ret_state_sample = jnp.stack(rs_s, axis=0)
    return (y_prompt, y_sample, fox_k_prompt, fox_v_prompt, fox_logf_prompt, ret_state_prompt,
            fox_k_sample, fox_v_sample, fox_logf_sample, ret_state_sample)
```

```cpp
#include <hip/hip_runtime.h>
#include <cstdio>
#include <cstdint>

#define LAS __attribute__((address_space(3)))
#define GAS __attribute__((address_space(1)))
typedef unsigned short bf16_t;
typedef short bf16x8 __attribute__((ext_vector_type(8)));
typedef short s16x4 __attribute__((ext_vector_type(4)));
typedef float f32x2 __attribute__((ext_vector_type(2)));
typedef float f32x4 __attribute__((ext_vector_type(4)));
typedef float f32x16 __attribute__((ext_vector_type(16)));
typedef unsigned u32x2 __attribute__((ext_vector_type(2)));
typedef unsigned u32x4 __attribute__((ext_vector_type(4)));
typedef GAS unsigned gu32;

constexpr int DM = 2048, SEQ = 16384, NMETA = 16, LP = NMETA + SEQ, DB = 16, DS = 64, PAST = 1024, SKS = PAST + DS;
constexpr int HF = 16, DHF = 128, HR = 8, DKR = 256, DVR = 512, DVT = 4096, DFF = 8192;
constexpr int NFOXIN = 4 * DM + HF, NRETIN = 12288;
constexpr int DFFP = DFF;
constexpr int ROW_PAD = 1024, ROW_P0 = 1264, MROWS = 17664, NTILE = 69;
constexpr int KB_ROWS = 34096;
constexpr int KB_PROMPT0 = 16384 + ROW_P0;
constexpr int BP_LEN = 16448;
constexpr float EPS = 1e-6f;
constexpr int SLAB_ROW0 = 16384, SLAB_ROWS = MROWS - SLAB_ROW0, NSLAB = 6;
constexpr size_t O_YP = 0, O_YS = O_YP + (size_t)SEQ * DM, O_FKP = O_YS + (size_t)DB * DS * DM, O_FVP = O_FKP + (size_t)2 * LP * DM, O_FLP = O_FVP + (size_t)2 * LP * DM,
                 O_RSP = O_FLP + (size_t)2 * LP * HF, O_FKS = O_RSP + (size_t)2 * HR * DKR * DVR, O_FVS = O_FKS + (size_t)2 * DB * DS * DM, O_FLS = O_FVS + (size_t)2 * DB * DS * DM,
                 O_RSS = O_FLS + (size_t)2 * DB * DS * HF, O_END = O_RSS + (size_t)2 * DB * HR * DKR * DVR;

__device__ __forceinline__ unsigned cvt_pk_bf16(float lo, float hi) { unsigned r; asm volatile("v_cvt_pk_bf16_f32 %0, %1, %2" : "=v"(r) : "v"(lo), "v"(hi)); return r; }
__device__ __forceinline__ float bf2f(unsigned short b) { return __uint_as_float(((unsigned)b) << 16); }
__device__ __forceinline__ u32x4 pack8f(f32x4 a, f32x4 b) { u32x4 w; w.x = cvt_pk_bf16(a[0], a[1]); w.y = cvt_pk_bf16(a[2], a[3]); w.z = cvt_pk_bf16(b[0], b[1]); w.w = cvt_pk_bf16(b[2], b[3]); return w; }
#ifndef ST16_MODE
#define ST16_MODE 0
#endif
__device__ __forceinline__ void st16(void* p, u32x4 v) {
#if ST16_MODE == 1
    asm volatile("global_store_dwordx4 %0, %1, off sc1" :: "v"(p), "v"(v) : "memory");
#elif ST16_MODE == 2
    asm volatile("global_store_dwordx4 %0, %1, off nt" :: "v"(p), "v"(v) : "memory");
#else
    *(u32x4*)p = v;
#endif
}
__device__ __forceinline__ float wave_sum(float v) {
#pragma unroll
    for (int o = 1; o < 64; o <<= 1) v += __shfl_xor(v, o);
    return v;
}
__device__ __forceinline__ int kv_rowmap(int r) { return r < ROW_PAD ? (r >> 6) * SKS + PAST + (r & 63) : 16384 + r; }
__device__ __forceinline__ int lane_id() { return (int)__builtin_amdgcn_mbcnt_hi(~0u, __builtin_amdgcn_mbcnt_lo(~0u, 0u)); }
__device__ __forceinline__ int lane_id_opaque() { int l; asm volatile("v_mbcnt_lo_u32_b32 %0, -1, 0\n\tv_mbcnt_hi_u32_b32 %0, -1, %0" : "=v"(l)); return l; }
__device__ __forceinline__ int opaque_zero() { int z; asm volatile("v_mov_b32 %0, 0" : "=v"(z)); return z; }
__device__ __forceinline__ float ret_lg2gamma(int h) { return __builtin_log2f(1.0f - __builtin_exp2f(-5.0f - (float)h)); }

namespace pg8 {
constexpr int BM = 256, BK = 64, HALF = 128, HTB = HALF * BK * 2, STAGE_BYTES = 8 * HTB, NXCD = 8;
__host__ __device__ __forceinline__ int lds_byte(int r, int c) { const int st = (r >> 4) * 2 + (c >> 5), rr = r & 15, cc = c & 31, ob = rr * 64 + cc * 2; return st * 1024 + (ob ^ (((ob >> 9) & 1) << 5)); }
__host__ __device__ __forceinline__ void stage_rc(int b, int& R, int& C) { const int st = b / 1024, sb = b % 1024, swz = sb ^ (((sb >> 9) & 1) << 5); R = (st >> 1) * 16 + swz / 64; C = (st & 1) * 32 + (swz % 64) / 2; }
__host__ __device__ __forceinline__ int perm32(int rho) { const int n = rho >> 4, i = rho & 15; return 8 * (i >> 2) + 4 * n + (i & 3); }

struct Unit { const char* a; const char* b; int pm, pn, kind, nt; };
struct Shape { int lda, ldb; };
template <int WG_M = 8>
__device__ __forceinline__ void tile_decode(int L, int nM, int nN, int& pm, int& pn) { constexpr int WGM = WG_M;
    const int nwg = nM * nN; int wgid = L;
    { const int q = nwg / NXCD, r = nwg % NXCD, xcd = wgid % NXCD, off = wgid / NXCD; wgid = (xcd < r ? xcd * (q + 1) : r * (q + 1) + (xcd - r) * q) + off; }
    const int nig = WGM * nN, gid = wgid / nig, fm = gid * WGM, gsz = (nM - fm) < WGM ? (nM - fm) : WGM;
    pm = fm + ((wgid % nig) % gsz); pn = (wgid % nig) / gsz;
}

template <class Epi, class Sched>
__device__ __forceinline__ void gemm_phase(LAS unsigned char* lds, const Shape g, const Sched& S, const Epi& E, const int wid) {
    const int lane = lane_id_opaque(), tid = wid * 64 + lane, wr = wid >> 2, wc = wid & 3, fr = lane & 15, fq = lane >> 4;
    unsigned voffA[2], voffB[2];
#pragma unroll
    for (int i = 0; i < 2; ++i) { int R, C; stage_rc(tid * 16 + i * 8192, R, C); const int Rb = Epi::PERM ? ((R & ~31) + perm32(R & 31)) : R;
        voffA[i] = (unsigned)(R * g.lda + C) * 2u; voffB[i] = (unsigned)(Rb * g.ldb + C) * 2u; }
    const size_t kstep = (size_t)(BK * 2);
    const size_t hstepA = (size_t)HALF * g.lda * 2, hstepB = (size_t)HALF * g.ldb * 2;
    const unsigned ldsw = (unsigned)wid * 1024u;
    const int aoff = lds_byte(wr * 64 + fr, fq * 8), boff = lds_byte(wc * 32 + fr, fq * 8);
#define PG8_SA(b, h) (((b) * 2 + (h)) * HTB)
#define PG8_SB(b, h) ((4 + (b) * 2 + (h)) * HTB)
#define PG8_STAGE(bufoff, gbase, voff) do { _Pragma("unroll") for (int _i = 0; _i < 2; ++_i) \
        __builtin_amdgcn_global_load_lds((const unsigned*)((const char*)(gbase) + (voff)[_i]), (LAS unsigned*)(lds + (bufoff) + ldsw + _i * 8192), 16, 0, 0); } while (0)
#define PG8_LDA(dst, b, h) do { _Pragma("unroll") for (int m = 0; m < 4; ++m) _Pragma("unroll") for (int k = 0; k < 2; ++k) dst[m][k] = *(const LAS bf16x8*)(lds + PG8_SA(b, h) + aoff + m * 2048 + k * 1024); } while (0)
#define PG8_LDB(dst, b, h) do { _Pragma("unroll") for (int n = 0; n < 2; ++n) _Pragma("unroll") for (int k = 0; k < 2; ++k) dst[n][k] = *(const LAS bf16x8*)(lds + PG8_SB(b, h) + boff + n * 2048 + k * 1024); } while (0)
#define PG8_MMA(ai, bj, At, Bt) do { __builtin_amdgcn_s_setprio(1); _Pragma("unroll") for (int m = 0; m < 4; ++m) _Pragma("unroll") for (int n = 0; n < 2; ++n) _Pragma("unroll") for (int k = 0; k < 2; ++k) \
        acc[ai][bj][m][n] = __builtin_amdgcn_mfma_f32_16x16x32_bf16(Bt[n][k], At[m][k], acc[ai][bj][m][n], 0, 0, 0); __builtin_amdgcn_s_setprio(0); } while (0)
#define PG8_WAIT_V(n) asm volatile("s_waitcnt vmcnt(" #n ")" ::: "memory")
#define PG8_WAIT_L(n) asm volatile("s_waitcnt lgkmcnt(" #n ")" ::: "memory")
#define PG8_BAR __builtin_amdgcn_s_barrier()
#define PG8_SCHED __builtin_amdgcn_sched_barrier(0)
    Unit cur, nxt; int ui = 0;
    if (!S.next(0, cur)) return;
    f32x4 acc[2][2][4][2];
#pragma unroll
    for (int a = 0; a < 2; ++a)
#pragma unroll
        for (int b = 0; b < 2; ++b)
#pragma unroll
            for (int m = 0; m < 4; ++m)
#pragma unroll
                for (int n = 0; n < 2; ++n) acc[a][b][m][n] = (f32x4){0.f, 0.f, 0.f, 0.f};
    bf16x8 At[4][2], B0[2][2], B1[2][2];
    const char* cA = cur.a; const char* cB = cur.b;
    PG8_STAGE(PG8_SB(0, 0), cB, voffB); PG8_STAGE(PG8_SB(0, 1), cB + hstepB, voffB); PG8_STAGE(PG8_SA(0, 0), cA, voffA); PG8_STAGE(PG8_SA(0, 1), cA + hstepA, voffA);
    if (wr == 1) PG8_BAR;
    PG8_WAIT_V(2); PG8_BAR;
    PG8_STAGE(PG8_SB(1, 0), cB + kstep, voffB); PG8_STAGE(PG8_SA(1, 0), cA + kstep, voffA); PG8_STAGE(PG8_SB(1, 1), cB + hstepB + kstep, voffB);
    PG8_WAIT_V(6); PG8_BAR;
    for (;;) {
        const bool has_next = S.next(ui + 1, nxt); const int nt = cur.nt;
        const char* nA = has_next ? nxt.a : cA; const char* nB = has_next ? nxt.b : cB;
#pragma nounroll
        for (int t = 0; t < nt; t += 2) {
            const bool last = (t == nt - 2);
            const char* a1 = cA + (size_t)(t + 1) * kstep;
            const char* a2 = last ? nA : cA + (size_t)(t + 2) * kstep; const char* b2 = last ? nB : cB + (size_t)(t + 2) * kstep;
            const char* a3 = a2 + kstep; const char* b3 = b2 + kstep;
            PG8_LDB(B0, 0, 0); PG8_LDB(B1, 0, 1); PG8_SCHED; PG8_LDA(At, 0, 0); PG8_STAGE(PG8_SA(1, 1), a1 + hstepA, voffA);
            PG8_WAIT_V(8); PG8_WAIT_L(0); PG8_BAR; PG8_MMA(0, 0, At, B0); PG8_MMA(0, 1, At, B1); PG8_BAR; PG8_SCHED;
            PG8_LDA(At, 0, 1); PG8_STAGE(PG8_SB(0, 0), b2, voffB); PG8_STAGE(PG8_SB(0, 1), b2 + hstepB, voffB); PG8_STAGE(PG8_SA(0, 0), a2, voffA);
            PG8_WAIT_V(8); PG8_WAIT_L(0); PG8_BAR; PG8_MMA(1, 0, At, B0); PG8_MMA(1, 1, At, B1); PG8_BAR; PG8_SCHED;
            PG8_LDB(B0, 1, 0); PG8_LDB(B1, 1, 1); PG8_SCHED; PG8_LDA(At, 1, 0); PG8_STAGE(PG8_SA(0, 1), a2 + hstepA, voffA);
            PG8_WAIT_V(8); PG8_WAIT_L(0); PG8_BAR; PG8_MMA(0, 0, At, B0); PG8_MMA(0, 1, At, B1); PG8_BAR; PG8_SCHED;
            PG8_LDA(At, 1, 1); PG8_STAGE(PG8_SB(1, 0), b3, voffB); PG8_STAGE(PG8_SB(1, 1), b3 + hstepB, voffB); PG8_STAGE(PG8_SA(1, 0), a3, voffA);
            PG8_WAIT_V(8); PG8_WAIT_L(0); PG8_BAR; PG8_MMA(1, 0, At, B0); PG8_MMA(1, 1, At, B1); PG8_BAR; PG8_SCHED;
        }
        if (wr == 0) PG8_BAR;
        E(acc, cur, wr, wc, fr, fq);
        E.side(ui, wid, lane);
        if (!has_next) break;
#pragma unroll
        for (int a = 0; a < 2; ++a)
#pragma unroll
            for (int b = 0; b < 2; ++b)
#pragma unroll
                for (int m = 0; m < 4; ++m)
#pragma unroll
                    for (int n = 0; n < 2; ++n) acc[a][b][m][n] = (f32x4){0.f, 0.f, 0.f, 0.f};
        cur = nxt; cA = nA; cB = nB; ++ui;
        if (wr == 1) PG8_BAR;
    }
    PG8_WAIT_V(0);
    PG8_BAR;
#undef PG8_SA
#undef PG8_SB
#undef PG8_STAGE
#undef PG8_LDA
#undef PG8_LDB
#undef PG8_MMA
#undef PG8_WAIT_V
#undef PG8_WAIT_L
#undef PG8_BAR
#undef PG8_SCHED
}
}
__device__ __forceinline__ void scan_job(int job, const float* lf, const float* clf, float* bP, float* bS, LAS double* sums, int wave);
namespace pg8 {
struct SchedFoxIn {
    const char* A; const char* Bt; int G, c;
    __device__ __forceinline__ bool next(int i, Unit& u) const {
        const long L = (long)i * G + c; if (L >= (long)NTILE * 33) return false;
        if (L < NTILE) { u.pm = (int)L; u.pn = 32; } else tile_decode<4>((int)L - NTILE, NTILE, 32, u.pm, u.pn);
        u.a = A + (size_t)u.pm * ((size_t)256 * DM * 2); u.b = Bt + (size_t)u.pn * ((size_t)256 * DM * 2); u.kind = 0; u.nt = DM / 64; return true; }
};
struct SchedSimple {
    const char* A; const char* Bt; int nM, nN, G, c; size_t astep, bstep; int nt;
    __device__ __forceinline__ bool next(int i, Unit& u) const {
        const long L = (long)i * G + c; if (L >= (long)nM * nN) return false;
        tile_decode<4>((int)L, nM, nN, u.pm, u.pn); u.a = A + (size_t)u.pm * astep; u.b = Bt + (size_t)u.pn * bstep; u.kind = 0; u.nt = nt; return true; }
};
struct SchedResid {
    const char* A; const char* Bt; int G, c; size_t astep, bstep; int nt;
    __device__ __forceinline__ bool next(int i, Unit& u) const {
        const long L = (long)i * G + c;
        if (L < 512) { tile_decode<4>((int)L, 64, 8, u.pm, u.pn);
            u.a = A + (size_t)u.pm * astep; u.b = Bt + (size_t)u.pn * bstep; u.kind = 0; u.nt = nt; return true; }
        const int s = (int)(L - 512); if (s >= 256) return false;
        int part, pmo, pno;
        if (G == 256) { const int g = 4 * (c & 7) + (c >> 6); if (g >= 30) return false; part = g / 5; pmo = g - 5 * part; pno = (c >> 3) & 7; }
        else { if (s >= 240) return false; const int q = s / 6; part = s - 6 * q; pmo = q >> 3; pno = q & 7; }
        const int e = nt >> 1, base = e / 6, r = e - 6 * base, k0 = part * base + (part < r ? part : r), np = base + (part < r ? 1 : 0);
        u.pm = 64 + pmo; u.pn = pno; u.kind = 1 + part; u.nt = 2 * np;
        u.a = A + (size_t)u.pm * astep + (size_t)k0 * 256; u.b = Bt + (size_t)u.pn * bstep + (size_t)k0 * 256; return true; }
};
struct SchedRetIn {
    const char* X; const char* W; int G, c;
    __device__ __forceinline__ bool next(int i, Unit& u) const {
        const long L = (long)i * G + c; constexpr int N0 = NTILE * 32, N1 = 16 * NTILE;
        if (L >= N0 + N1) return false;
        constexpr size_t ts = (size_t)256 * DM * 2;
        if (L < N0) { int pm, pn; tile_decode<4>((int)L, NTILE, 32, pm, pn); const int wt = pn < 16 ? pn : pn + 16;
            u.pm = pm; u.pn = wt; u.kind = 0; u.nt = DM / 64; u.a = X + (size_t)pm * ts; u.b = W + (size_t)wt * ts; }
        else { int pm, pn; tile_decode<4>((int)(L - N0), 16, NTILE, pm, pn); u.pm = pm; u.pn = pn; u.kind = 3; u.nt = DM / 64; u.a = W + (size_t)(16 + pm) * ts; u.b = X + (size_t)pn * ts; }
        return true; }
};
struct SchedG1 {
    const char* AP; const char* KRN; int G, c;
    __device__ __forceinline__ bool next(int i, Unit& u) const {
        const long L = (long)i * G + c; if (L >= NTILE * HR) return false;
        const int head = (int)L & 7, pm = (int)L >> 3; u.pm = pm; u.pn = 0; u.kind = head; u.nt = 4;
        u.a = AP + (((size_t)head * MROWS + (size_t)pm * 256) * 512 + 256) * 2; u.b = KRN + ((size_t)pm * 256 * DM + head * 256) * 2; return true; }
};
struct SchedG2p {
    const char* BT; const char* KTP; int G, c;
    __device__ __forceinline__ bool next(int i, Unit& u) const {
        const long L = (long)i * G + c; if (L >= HR * 65 * 2) return false;
        const int half = (int)L & 1, head = ((int)L >> 1) & 7, blk = (int)L >> 4; u.pm = blk; u.pn = half; u.kind = head; u.nt = 4;
        u.a = BT + ((((size_t)head * 65 + blk) * 512 + half * 256) * 512) * 2; u.b = KTP + ((size_t)head * 256 * MROWS + (size_t)(blk + 4) * 256) * 2; return true; }
};
struct SchedG2s {
    const char* KTS; const char* BTS; int G, c;
    __device__ __forceinline__ bool next(int i, Unit& u) const {
        const long L = (long)i * G + c; if (L >= DB * HR * 2) return false;
        const int half = (int)L & 1, head = ((int)L >> 1) & 7, b = (int)L >> 4, tile = b >> 2, bb = b & 3; u.pm = b; u.pn = half; u.kind = head; u.nt = 4;
        u.a = KTS + ((((size_t)head * 4 + tile) * 4 + bb) * 256 * 256) * 2; u.b = BTS + ((((size_t)head * 4 + tile) * 512 + half * 256) * 1280) * 2; return true; }
};
struct SchedG3p {
    const char* AP; const char* BT; int G, c;
    __device__ __forceinline__ bool next(int i, Unit& u) const {
        long p = (long)(i >> 1) * G + c;
        if (G == 256) { const int r = i >> 1;
            if (r == 0) p = c; else if (r == 1) { if (c >= 224) return false; p = 256 + c; } else if (r == 2) { if (c >= 40) return false; p = 480 + c; } else return false; }
        if (p >= HR * 65) return false;
        const int half = i & 1, head = (int)p & 7, blk = (int)p >> 3; u.pm = blk + 4; u.pn = half; u.kind = head; u.nt = 8;
        u.a = AP + (((size_t)head * MROWS + (size_t)(blk + 4) * 256) * 512) * 2; u.b = BT + ((((size_t)head * 65 + blk) * 512 + half * 256) * 512) * 2; return true; }
};
struct SchedG3s {
    const char* APS; const char* BTS; int G, c;
    __device__ __forceinline__ bool next(int i, Unit& u) const {
        const long p = (long)(i >> 1) * G + (G - 1 - c); if (p >= HR * 4) return false;
        const int half = i & 1, head = (int)p & 7, tile = (int)p >> 3; u.pm = tile; u.pn = half; u.kind = head; u.nt = 20;
        u.a = APS + (((size_t)head * 1024 + (size_t)tile * 256) * 1280) * 2; u.b = BTS + ((((size_t)head * 4 + tile) * 512 + half * 256) * 1280) * 2; return true; }
};

typedef const f32x4 (&AccRef)[2][2][4][2];

struct EpiResid { static constexpr bool PERM = false; float* H; float* SLAB;
    __device__ __forceinline__ void operator()(AccRef acc, const Unit& u, int wr, int wc, int fr, int fq) const {
        const int row0 = u.pm * BM + wr * 64 + fr + opaque_zero(), col0 = u.pn * BM + wc * 32 + 4 * fq + opaque_zero();
        if (u.kind == 0) {
#pragma unroll
            for (int ai = 0; ai < 2; ++ai)
#pragma unroll
                for (int mp = 0; mp < 2; ++mp) { f32x4 t[2][2][2];
#pragma unroll
                    for (int mm = 0; mm < 2; ++mm) { const float* rowp = H + (size_t)(row0 + ai * HALF + (2 * mp + mm) * 16) * DM + col0;
#pragma unroll
                        for (int bj = 0; bj < 2; ++bj)
#pragma unroll
                            for (int n = 0; n < 2; ++n) t[mm][bj][n] = *(const f32x4*)(rowp + bj * HALF + n * 16); }
                    asm volatile("" ::: "memory");
#pragma unroll
                    for (int mm = 0; mm < 2; ++mm) { float* rowp = H + (size_t)(row0 + ai * HALF + (2 * mp + mm) * 16) * DM + col0;
#pragma unroll
                        for (int bj = 0; bj < 2; ++bj)
#pragma unroll
                            for (int n = 0; n < 2; ++n) *(f32x4*)(rowp + bj * HALF + n * 16) = t[mm][bj][n] + acc[ai][bj][2 * mp + mm][n]; } }
        } else {
            bf16_t* sl = (bf16_t*)SLAB + (size_t)(u.kind - 1) * SLAB_ROWS * DM;
#pragma unroll
            for (int ai = 0; ai < 2; ++ai)
#pragma unroll
                for (int m = 0; m < 4; ++m) { bf16_t* rowp = sl + (size_t)(row0 - SLAB_ROW0 + ai * HALF + m * 16) * DM + col0;
#pragma unroll
                    for (int bj = 0; bj < 2; ++bj)
#pragma unroll
                        for (int n = 0; n < 2; ++n) { const f32x4 a = acc[ai][bj][m][n]; u32x2 w; w.x = cvt_pk_bf16(a[0], a[1]); w.y = cvt_pk_bf16(a[2], a[3]); *(u32x2*)(rowp + bj * HALF + n * 16) = w; } }
        }
    }
    __device__ __forceinline__ void side(int, int, int) const {}
};
struct EpiUp { static constexpr bool PERM = true; bf16_t* U;
    __device__ __forceinline__ void operator()(AccRef acc, const Unit& u, int wr, int wc, int fr, int fq) const {
        const int row0 = u.pm * BM + wr * 64 + fr + opaque_zero(), col0 = u.pn * BM + wc * 32 + 8 * fq + opaque_zero();
#pragma unroll
        for (int ai = 0; ai < 2; ++ai)
#pragma unroll
            for (int m = 0; m < 4; ++m) { bf16_t* rowp = U + (size_t)(row0 + ai * HALF + m * 16) * DFFP + col0;
#pragma unroll
                for (int bj = 0; bj < 2; ++bj) { f32x4 v0 = acc[ai][bj][m][0], v1 = acc[ai][bj][m][1];
#pragma unroll
                    for (int j = 0; j < 4; ++j) { const float a = fmaxf(v0[j], 0.f), b = fmaxf(v1[j], 0.f); v0[j] = a * a; v1[j] = b * b; }
                    st16(rowp + bj * HALF, pack8f(v0, v1)); } }
    }
    __device__ __forceinline__ void side(int, int, int) const {}
};
__device__ __forceinline__ float log_sigmoid_f(float x) { return x >= 0.f ? -log1pf(__expf(-x)) : x - log1pf(__expf(x)); }
__device__ __forceinline__ float sigmoid_f(float x) { return 1.0f / (1.0f + __expf(-x)); }
struct EpiFoxIn { static constexpr bool PERM = true;
    bf16_t *qbuf, *kbuf, *vbuf, *gbuf; float* lf; const float *gq, *gk, *bfb; float *okp, *ovp, *olp, *oks, *ovs, *ols; LAS float* xl; const float *CK, *CV;
    unsigned* cnt; const float* clf; float *bPp, *bSp;
    __device__ __forceinline__ void operator()(AccRef acc, const Unit& u, int wr, int wc, int fr, int fq) const {
        const int kind = u.pn >> 3, rt0 = wr * 64 + fr + opaque_zero(), dcol = wc * 32 + 8 * fq + opaque_zero();
        if (kind <= 1) {
#pragma unroll
            for (int ai = 0; ai < 2; ++ai)
#pragma unroll
                for (int m = 0; m < 4; ++m)
#pragma unroll
                    for (int bj = 0; bj < 2; ++bj) { const f32x4 a = acc[ai][bj][m][0], b = acc[ai][bj][m][1];
                        float s = (a[0] * a[0] + a[1] * a[1]) + (a[2] * a[2] + a[3] * a[3]) + (b[0] * b[0] + b[1] * b[1]) + (b[2] * b[2] + b[3] * b[3]);
                        s += __shfl_xor(s, 16); s += __shfl_xor(s, 32);
                        if (fq == 0) xl[((ai * HALF + rt0 + m * 16) * 2 + bj) * 4 + wc] = s; }
            asm volatile("s_waitcnt lgkmcnt(0)" ::: "memory"); __builtin_amdgcn_s_barrier(); asm volatile("" ::: "memory");
            const float* g = kind == 0 ? gq : gk; const f32x4 g0 = *(const f32x4*)(g + dcol), g1 = *(const f32x4*)(g + dcol + 4);
#pragma unroll
            for (int ai = 0; ai < 2; ++ai)
#pragma unroll
                for (int m = 0; m < 4; ++m) { const int rt = ai * HALF + rt0 + m * 16, row = u.pm * BM + rt;
#pragma unroll
                    for (int bj = 0; bj < 2; ++bj) { const f32x4 pp = *(const LAS f32x4*)(xl + (rt * 2 + bj) * 4);
                        const float rs = __builtin_amdgcn_rsqf(((pp[0] + pp[1]) + (pp[2] + pp[3])) * (1.0f / 128.0f) + EPS);
                        const f32x4 v0 = acc[ai][bj][m][0] * rs * g0, v1 = acc[ai][bj][m][1] * rs * g1; const int colh = (u.pn & 7) * BM + bj * HALF + dcol;
                        if (kind == 0) *(u32x4*)(qbuf + (size_t)row * DM + colh) = pack8f(v0, v1);
                        else { *(u32x4*)(kbuf + (size_t)kv_rowmap(row) * DM + colh) = pack8f(v0, v1);
                            float* o = row < ROW_PAD ? oks + (size_t)row * DM + colh : (row >= ROW_P0 ? okp + (size_t)(row - ROW_P0) * DM + colh : nullptr);
                            if (o) { *(f32x4*)o = v0; *(f32x4*)(o + 4) = v1; } } } }
        } else if (kind == 2) {
#pragma unroll
            for (int ai = 0; ai < 2; ++ai)
#pragma unroll
                for (int m = 0; m < 4; ++m) { const int rt = ai * HALF + rt0 + m * 16, row = u.pm * BM + rt;
#pragma unroll
                    for (int bj = 0; bj < 2; ++bj) { const f32x4 v0 = acc[ai][bj][m][0], v1 = acc[ai][bj][m][1]; const int colh = (u.pn & 7) * BM + bj * HALF + dcol;
                        *(u32x4*)(vbuf + (size_t)kv_rowmap(row) * DM + colh) = pack8f(v0, v1);
                        float* o = row < ROW_PAD ? ovs + (size_t)row * DM + colh : (row >= ROW_P0 ? ovp + (size_t)(row - ROW_P0) * DM + colh : nullptr);
                        if (o) { *(f32x4*)o = v0; *(f32x4*)(o + 4) = v1; } } }
        } else if (kind == 3) {
#pragma unroll
            for (int ai = 0; ai < 2; ++ai)
#pragma unroll
                for (int m = 0; m < 4; ++m) { const int rt = ai * HALF + rt0 + m * 16, row = u.pm * BM + rt;
#pragma unroll
                    for (int bj = 0; bj < 2; ++bj) { f32x4 v0 = acc[ai][bj][m][0], v1 = acc[ai][bj][m][1]; const int colh = (u.pn & 7) * BM + bj * HALF + dcol;
#pragma unroll
                        for (int j = 0; j < 4; ++j) { v0[j] = sigmoid_f(v0[j]); v1[j] = sigmoid_f(v1[j]); }
                        *(u32x4*)(gbuf + (size_t)row * DM + colh) = pack8f(v0, v1); } }
        } else {
            if (wc == 0 && dcol < 16) {
#pragma unroll
                for (int ai = 0; ai < 2; ++ai)
#pragma unroll
                    for (int m = 0; m < 4; ++m) { const int rt = ai * HALF + rt0 + m * 16, row = u.pm * BM + rt;
#pragma unroll
                        for (int n = 0; n < 2; ++n) { const int hd = dcol + 4 * n; const f32x4 bb = *(const f32x4*)(bfb + hd); f32x4 v = acc[ai][0][m][n] + bb;
#pragma unroll
                            for (int j = 0; j < 4; ++j) v[j] = log_sigmoid_f(v[j]);
                            if (cnt) { unsigned long long* lp = (unsigned long long*)(lf + (size_t)row * HF + hd);
                                __hip_atomic_store(lp, (unsigned long long)__float_as_uint(v[0]) | ((unsigned long long)__float_as_uint(v[1]) << 32), __ATOMIC_RELAXED, __HIP_MEMORY_SCOPE_AGENT);
                                __hip_atomic_store(lp + 1, (unsigned long long)__float_as_uint(v[2]) | ((unsigned long long)__float_as_uint(v[3]) << 32), __ATOMIC_RELAXED, __HIP_MEMORY_SCOPE_AGENT); }
                            else *(f32x4*)(lf + (size_t)row * HF + hd) = v;
                            float* o = row < ROW_PAD ? ols + (size_t)row * HF + hd : (row >= ROW_P0 ? olp + (size_t)(row - ROW_P0) * HF + hd : nullptr);
                            if (o) *(f32x4*)o = v; } }
            }
            if (cnt) { asm volatile("s_waitcnt vmcnt(0)" ::: "memory"); __builtin_amdgcn_s_barrier(); asm volatile("" ::: "memory");
                if (wr == 0 && wc == 0 && fr == 0 && fq == 0) (void)__hip_atomic_fetch_add(cnt, 1u, __ATOMIC_RELAXED, __HIP_MEMORY_SCOPE_AGENT); }
        }
    }
    __device__ __forceinline__ void side(int ui, int wid, int lane) const {
        if (CK && ui < 8) {
#pragma unroll
            for (int q = 0; q < 2; ++q) { const int t = ((int)blockIdx.x * 8 + ui) * 16 + 2 * wid + q, which = t >> 14, r = t & 16383;
                const f32x4* s = (const f32x4*)((which ? CV : CK) + (size_t)r * DM) + lane; u32x2* d = (u32x2*)((which ? vbuf : kbuf) + ((size_t)(r >> 10) * SKS + (r & 1023)) * DM) + lane;
                f32x4 y[8];
#pragma unroll
                for (int j = 0; j < 8; ++j) y[j] = s[64 * j];
#pragma unroll
                for (int j = 0; j < 8; ++j) { u32x2 w; w.x = cvt_pk_bf16(y[j][0], y[j][1]); w.y = cvt_pk_bf16(y[j][2], y[j][3]); d[64 * j] = w; } }
        }
        if (cnt && ui == 7 && (int)blockIdx.x >= 229) {
            if (wid == 0 && lane == 0) { unsigned sp = 0u; while (__hip_atomic_load(cnt, __ATOMIC_RELAXED, __HIP_MEMORY_SCOPE_AGENT) < (unsigned)NTILE) { __builtin_amdgcn_s_sleep(1); if (++sp > (1u << 22)) break; } }
            __syncthreads(); __builtin_amdgcn_fence(__ATOMIC_ACQUIRE, "agent"); asm volatile("s_waitcnt vmcnt(0)" ::: "memory");
            const int j0 = (int)blockIdx.x - 229;
            scan_job(j0, lf, clf, bPp, bSp, (LAS double*)xl, wid);
            if (j0 + 27 < 32) { __syncthreads(); scan_job(j0 + 27, lf, clf, bPp, bSp, (LAS double*)xl, wid); }
        }
    }
};
struct EpiRetIn { static constexpr bool PERM = true;
    bf16_t *AP, *APS, *krn, *sg, *BT, *BTS; const float *COS, *SIN;
    __device__ __forceinline__ void operator()(AccRef acc, const Unit& u, int wr, int wc, int fr, int fq) const {
        const int rt0 = wr * 64 + fr + opaque_zero(), dcol = wc * 32 + 8 * fq + opaque_zero();
        if (u.kind == 3) {
            const int head = u.pm >> 1;
#pragma unroll
            for (int ai = 0; ai < 2; ++ai)
#pragma unroll
                for (int m = 0; m < 4; ++m) { const int rt = ai * HALF + rt0 + m * 16, dvl = (u.pm & 1) * 256 + rt;
#pragma unroll
                    for (int bj = 0; bj < 2; ++bj) { const int tk = bj * HALF + dcol; u32x4 w = pack8f(acc[ai][bj][m][0], acc[ai][bj][m][1]);
                        if (u.pn >= 4) { if (u.pn == 4 && tk < 240) w = (u32x4){0u, 0u, 0u, 0u};
                            *(u32x4*)(BT + ((((size_t)head * 65 + (u.pn - 4)) * 512 + dvl) * 512 + tk)) = w; }
                        else *(u32x4*)(BTS + ((((size_t)head * 4 + u.pn) * 512 + dvl) * 1280 + tk)) = w; } }
        } else if (u.pn < 16) {
            const bool isq = u.pn < 8; const int head = u.pn & 7; const float lg = ret_lg2gamma(head);
#pragma unroll
            for (int ai = 0; ai < 2; ++ai)
#pragma unroll
                for (int m = 0; m < 4; ++m) { const int rt = ai * HALF + rt0 + m * 16, row = u.pm * BM + rt;
                    const int pos = row < ROW_PAD ? NMETA + PAST + (row & 63) : (row >= ROW_P0 ? row - ROW_P0 : 0);
                    const float e = (float)((row < ROW_PAD ? (row & 63) : (row & 255)) + 1);
                    float f = isq ? __builtin_amdgcn_exp2f(lg * e) : 0.0625f * __builtin_amdgcn_exp2f(-lg * e);
                    if (!isq && row >= ROW_PAD && row < ROW_P0) f = 0.f;
                    f32x4 o1[2], o2[2];
#pragma unroll
                    for (int n = 0; n < 2; ++n) { const f32x4 cs = *(const f32x4*)(COS + (size_t)pos * 128 + dcol + 4 * n), sn = *(const f32x4*)(SIN + (size_t)pos * 128 + dcol + 4 * n);
                        const f32x4 x1 = acc[ai][0][m][n], x2 = acc[ai][1][m][n]; o1[n] = (x1 * cs - x2 * sn) * f; o2[n] = (x1 * sn + x2 * cs) * f; }
                    const u32x4 w1 = pack8f(o1[0], o1[1]), w2 = pack8f(o2[0], o2[1]);
                    if (isq) { bf16_t* d = AP + (((size_t)head * MROWS + row) * 512 + 256 + dcol); *(u32x4*)d = w1; *(u32x4*)(d + 128) = w2;
                        if (row < ROW_PAD) { bf16_t* ds = APS + (((size_t)head * 1024 + row) * 1280 + 256 + dcol); const int slot = (row >> 6) & 3; const u32x4 z = (u32x4){0u, 0u, 0u, 0u};
#pragma unroll
                            for (int s = 0; s < 4; ++s) { *(u32x4*)(ds + s * 256) = s == slot ? w1 : z; *(u32x4*)(ds + s * 256 + 128) = s == slot ? w2 : z; } } }
                    else { bf16_t* d = krn + ((size_t)row * DM + head * 256 + dcol); *(u32x4*)d = w1; *(u32x4*)(d + 128) = w2; } }
        } else {
#pragma unroll
            for (int ai = 0; ai < 2; ++ai)
#pragma unroll
                for (int m = 0; m < 4; ++m) { const int rt = ai * HALF + rt0 + m * 16, row = u.pm * BM + rt;
#pragma unroll
                    for (int bj = 0; bj < 2; ++bj) { f32x4 v0 = acc[ai][bj][m][0], v1 = acc[ai][bj][m][1];
#pragma unroll
                        for (int j = 0; j < 4; ++j) { v0[j] = v0[j] * sigmoid_f(v0[j]); v1[j] = v1[j] * sigmoid_f(v1[j]); }
                        *(u32x4*)(sg + (size_t)row * DVT + (u.pn - 32) * BM + bj * HALF + dcol) = pack8f(v0, v1); } }
        }
    }
    __device__ __forceinline__ void side(int, int, int) const {}
};
struct EpiG1 { static constexpr bool PERM = true; bf16_t *AP, *APS;
    __device__ __forceinline__ void operator()(AccRef acc, const Unit& u, int wr, int wc, int fr, int fq) const {
        const int rt0 = wr * 64 + fr + opaque_zero(), dcol = wc * 32 + 8 * fq + opaque_zero(), head = u.kind;
#pragma unroll
        for (int ai = 0; ai < 2; ++ai)
#pragma unroll
            for (int m = 0; m < 4; ++m) { const int i = ai * HALF + rt0 + m * 16, row = u.pm * BM + i;
#pragma unroll
                for (int bj = 0; bj < 2; ++bj) { const int j0 = bj * HALF + dcol; f32x4 v0 = acc[ai][bj][m][0], v1 = acc[ai][bj][m][1];
#pragma unroll
                    for (int jj = 0; jj < 4; ++jj) { const int ja = j0 + jj, jb = j0 + 4 + jj;
                        const bool oka = ja <= i && (u.pm >= 4 || (ja >> 6) == (i >> 6)), okb = jb <= i && (u.pm >= 4 || (jb >> 6) == (i >> 6));
                        v0[jj] = oka ? v0[jj] : 0.f; v1[jj] = okb ? v1[jj] : 0.f; }
                    bf16_t* d = u.pm >= 4 ? AP + (((size_t)head * MROWS + row) * 512 + j0) : APS + (((size_t)head * 1024 + row) * 1280 + j0);
                    *(u32x4*)d = pack8f(v0, v1); } }
    }
    __device__ __forceinline__ void side(int, int, int) const {}
};
struct EpiG2p { static constexpr bool PERM = true; bf16_t* BT;
    __device__ __forceinline__ void operator()(AccRef acc, const Unit& u, int wr, int wc, int fr, int fq) const {
        const int rt0 = wr * 64 + fr + opaque_zero(), dcol = wc * 32 + 8 * fq + opaque_zero(), head = u.kind; const float g256 = __builtin_amdgcn_exp2f(ret_lg2gamma(head) * 256.0f);
#pragma unroll
        for (int ai = 0; ai < 2; ++ai)
#pragma unroll
            for (int m = 0; m < 4; ++m) { const int dvl = u.pn * 256 + ai * HALF + rt0 + m * 16;
#pragma unroll
                for (int bj = 0; bj < 2; ++bj)
                    *(u32x4*)(BT + ((((size_t)head * 65 + u.pm) * 512 + dvl) * 512 + 256 + bj * HALF + dcol)) = pack8f(acc[ai][bj][m][0] * g256, acc[ai][bj][m][1] * g256); }
    }
    __device__ __forceinline__ void side(int, int, int) const {}
};
struct EpiG2s { static constexpr bool PERM = false; const float* S0; float* OUT;
    __device__ __forceinline__ void operator()(AccRef acc, const Unit& u, int wr, int wc, int fr, int fq) const {
        const int rt0 = wr * 64 + fr + opaque_zero(), col0 = u.pn * 256 + wc * 32 + 4 * fq + opaque_zero(), head = u.kind; const float g64 = __builtin_amdgcn_exp2f(ret_lg2gamma(head) * 64.0f);
        const size_t base = ((size_t)u.pm * HR + head) * DKR * DVR;
#pragma unroll
        for (int ai = 0; ai < 2; ++ai)
#pragma unroll
            for (int m = 0; m < 4; ++m) { const int dk = ai * HALF + rt0 + m * 16; const size_t ro = base + (size_t)dk * DVR + col0; f32x4 t[2][2];
#pragma unroll
                for (int bj = 0; bj < 2; ++bj)
#pragma unroll
                    for (int n = 0; n < 2; ++n) t[bj][n] = *(const f32x4*)(S0 + ro + bj * HALF + n * 16);
#pragma unroll
                for (int bj = 0; bj < 2; ++bj)
#pragma unroll
                    for (int n = 0; n < 2; ++n) *(f32x4*)(OUT + ro + bj * HALF + n * 16) = (t[bj][n] + acc[ai][bj][m][n]) * g64; }
    }
    __device__ __forceinline__ void side(int, int, int) const {}
};
struct EpiG3 { static constexpr bool PERM = true; bf16_t* OB; const bf16_t* SG; const float* GN; LAS float* xl; LAS float* xs;
    __device__ __forceinline__ void operator()(AccRef acc, const Unit& u, int wr, int wc, int fr, int fq) const {
        const int rt0 = wr * 64 + fr + opaque_zero(), dcol = wc * 32 + 8 * fq + opaque_zero(), head = u.kind;
#pragma unroll
        for (int ai = 0; ai < 2; ++ai)
#pragma unroll
            for (int m = 0; m < 4; ++m) { float s = 0.f;
#pragma unroll
                for (int bj = 0; bj < 2; ++bj) { const f32x4 a = acc[ai][bj][m][0], b = acc[ai][bj][m][1];
                    s += (a[0] * a[0] + a[1] * a[1]) + (a[2] * a[2] + a[3] * a[3]) + (b[0] * b[0] + b[1] * b[1]) + (b[2] * b[2] + b[3] * b[3]); }
                s += __shfl_xor(s, 16); s += __shfl_xor(s, 32);
                if (fq == 0) xl[(ai * HALF + rt0 + m * 16) * 4 + wc] = s; }
        asm volatile("s_waitcnt lgkmcnt(0)" ::: "memory"); __builtin_amdgcn_s_barrier(); asm volatile("" ::: "memory");
        if (u.pn == 0) {
#pragma unroll
            for (int ai = 0; ai < 2; ++ai)
#pragma unroll
                for (int m = 0; m < 4; ++m) { const int rt = ai * HALF + rt0 + m * 16, row = u.pm * BM + rt;
                    if (wc == 0 && fq == 0) { const f32x4 pp = *(const LAS f32x4*)(xl + rt * 4); xs[rt] = (pp[0] + pp[1]) + (pp[2] + pp[3]); }
#pragma unroll
                    for (int bj = 0; bj < 2; ++bj) *(u32x4*)(OB + (size_t)row * DVT + head * 512 + bj * HALF + dcol) = pack8f(acc[ai][bj][m][0], acc[ai][bj][m][1]); }
        } else {
            f32x4 gn[2][2][2];
#pragma unroll
            for (int hf = 0; hf < 2; ++hf)
#pragma unroll
                for (int bj = 0; bj < 2; ++bj) { const int cl = hf * 256 + bj * HALF + dcol; gn[hf][bj][0] = *(const f32x4*)(GN + head * DVR + cl); gn[hf][bj][1] = *(const f32x4*)(GN + head * DVR + cl + 4); }
            u32x4 gvv[1][2][2], ovv[1][2];
#define G3_LOAD(buf, g_) do { const size_t ro_ = (size_t)(u.pm * BM + ((g_) >> 2) * HALF + rt0 + ((g_) & 3) * 16) * DVT + head * 512 + dcol; \
                _Pragma("unroll") for (int hf = 0; hf < 2; ++hf) _Pragma("unroll") for (int bj = 0; bj < 2; ++bj) gvv[buf][hf][bj] = *(const u32x4*)(SG + ro_ + hf * 256 + bj * HALF); \
                _Pragma("unroll") for (int bj = 0; bj < 2; ++bj) ovv[buf][bj] = *(const u32x4*)(OB + ro_ + bj * HALF); } while (0)
#pragma unroll
            for (int g = 0; g < 8; ++g) { const int ai = g >> 2, m = g & 3, cb = 0, rt = ai * HALF + rt0 + m * 16, row = u.pm * BM + rt;
                G3_LOAD(0, g); asm volatile("" ::: "memory");
                const f32x4 pp = *(const LAS f32x4*)(xl + rt * 4);
                const float rs = 1.0f / sqrtf((((pp[0] + pp[1]) + (pp[2] + pp[3])) + xs[rt]) * (1.0f / DVR) + EPS);
#pragma unroll
                for (int hf = 0; hf < 2; ++hf)
#pragma unroll
                    for (int bj = 0; bj < 2; ++bj) { const int cl = hf * 256 + bj * HALF + dcol; bf16_t* op = OB + (size_t)row * DVT + head * 512 + cl;
                        const u32x4 gv = gvv[cb][hf][bj]; const f32x4 n0 = gn[hf][bj][0], n1 = gn[hf][bj][1];
                        f32x4 v0, v1;
                        if (hf == 1) { v0 = acc[ai][bj][m][0]; v1 = acc[ai][bj][m][1]; }
                        else { const u32x4 ov = ovv[cb][bj]; v0[0] = __uint_as_float(ov[0] << 16); v0[1] = __uint_as_float(ov[0] & 0xffff0000u); v0[2] = __uint_as_float(ov[1] << 16); v0[3] = __uint_as_float(ov[1] & 0xffff0000u);
                            v1[0] = __uint_as_float(ov[2] << 16); v1[1] = __uint_as_float(ov[2] & 0xffff0000u); v1[2] = __uint_as_float(ov[3] << 16); v1[3] = __uint_as_float(ov[3] & 0xffff0000u); }
                        f32x4 g0, g1; g0[0] = __uint_as_float(gv[0] << 16); g0[1] = __uint_as_float(gv[0] & 0xffff0000u); g0[2] = __uint_as_float(gv[1] << 16); g0[3] = __uint_as_float(gv[1] & 0xffff0000u);
                        g1[0] = __uint_as_float(gv[2] << 16); g1[1] = __uint_as_float(gv[2] & 0xffff0000u); g1[2] = __uint_as_float(gv[3] << 16); g1[3] = __uint_as_float(gv[3] & 0xffff0000u);
                        *(u32x4*)op = pack8f(v0 * rs * n0 * g0, v1 * rs * n1 * g1); } }
#undef G3_LOAD
        }
    }
    __device__ __forceinline__ void side(int, int, int) const {}
};
}
namespace fa {
constexpr int NW = 8, QBLK = 32, KVBLK = 64, QB = NW * QBLK, D = 128, PITCH = DM;
constexpr int SHM_V = KVBLK * D * 2, SHM_K = KVBLK * D * 2;
constexpr int OFF_K = 2 * SHM_V, OFF_WS = OFF_K + 2 * SHM_K, OFF_B = OFF_WS + NW * 64 * 4, OFF_Q = OFF_B + 2 * 64 * 4, OFF_QL = 68608  , LDS_BYTES = OFF_QL + NW * 8192;
static_assert(OFF_Q + 64 <= OFF_QL, "lds map");
constexpr float C2 = 0.08838834764831845f * 1.4426950408889634f, THR2 = 8.0f * 1.4426950408889634f;

#define KSWZ(row, colB) ((row) * 256 + ((colB) ^ (((row) & 7) << 4)))
#define SBAR() __builtin_amdgcn_sched_barrier(0)
__device__ __forceinline__ int v_st(int k, int c) { const int kk = (k & ~0xC) | ((k & 4) << 1) | ((k & 8) >> 1); return ((kk >> 3) * 4 + (c >> 5)) * 512 + ((kk & 7) * 32 + (c & 31)) * 2; }
__device__ __forceinline__ int v_rd_base(int lane) { return ((lane & 3) << 3) | (((lane >> 2) & 3) << 6) | (((lane >> 4) & 1) << 5) | (((lane >> 5) & 1) << 8); }
constexpr int v_rd_off(int d0, int ks, int half) { return d0 * 512 + ks * 4096 + half * 2048; }
__device__ __forceinline__ int crow(int r, int hi) { return (r & 3) + 8 * (r >> 2) + 4 * hi; }
__device__ __forceinline__ bf16x8 load8(const bf16_t* p) { return *reinterpret_cast<const bf16x8*>(p); }
__device__ __forceinline__ void mask_tile(f32x16& p0, f32x16& p1, int dq) {
    const float NEG = -__builtin_inff();
#pragma unroll
    for (int r = 0; r < 16; ++r) { const int c = (r & 3) + 8 * (r >> 2); if (dq - c < 0) p0[r] = NEG; if (dq - c - 32 < 0) p1[r] = NEG; }
}
__device__ __forceinline__ void partialSM(f32x16& p0, f32x16& p1, float& m_reg, float& mn, float& alpha, const float* bl, int hi) {
#pragma unroll
    for (int g = 0; g < 4; ++g) { const f32x4 b0 = *(const f32x4*)(bl + 8 * g + 4 * hi), b1 = *(const f32x4*)(bl + 32 + 8 * g + 4 * hi);
#pragma unroll
        for (int j = 0; j < 4; ++j) { p0[4 * g + j] = fmaf(p0[4 * g + j], C2, b0[j]); p1[4 * g + j] = fmaf(p1[4 * g + j], C2, b1[j]); } }
    float pmax = p0[0];
#pragma unroll
    for (int r = 1; r < 16; ++r) pmax = fmaxf(pmax, p0[r]);
#pragma unroll
    for (int r = 0; r < 16; ++r) pmax = fmaxf(pmax, p1[r]);
    { auto rr = __builtin_amdgcn_permlane32_swap(__float_as_uint(pmax), __float_as_uint(pmax), false, false);
      pmax = fmaxf(__uint_as_float(rr[0]), __uint_as_float(rr[1])); }
    if (__builtin_expect(__all(pmax - m_reg <= THR2), 1)) { mn = m_reg; alpha = 1.f; }
    else { mn = fmaxf(m_reg, pmax); alpha = __builtin_amdgcn_exp2f(m_reg - mn); m_reg = mn; }
#pragma unroll
    for (int r = 0; r < 16; ++r) { p0[r] = p0[r] - mn; p1[r] = p1[r] - mn; }
#pragma unroll
    for (int r = 0; r < 16; ++r) p0[r] = __builtin_amdgcn_exp2f(p0[r]);
}
__device__ __forceinline__ void finishSM(f32x16& p0, f32x16& p1, float alpha, float& l_reg, bf16x8& pa0, bf16x8& pa1, bf16x8& pa2, bf16x8& pa3) {
#pragma unroll
    for (int r = 0; r < 16; ++r) p1[r] = __builtin_amdgcn_exp2f(p1[r]);
    float ps = 0;
#pragma unroll
    for (int r = 0; r < 16; ++r) ps += p0[r];
#pragma unroll
    for (int r = 0; r < 16; ++r) ps += p1[r];
    { auto rr = __builtin_amdgcn_permlane32_swap(__float_as_uint(ps), __float_as_uint(ps), false, false);
      ps = __uint_as_float(rr[0]) + __uint_as_float(rr[1]); }
    l_reg = l_reg * alpha + ps;
#define PK4(P, B_, OUT) do { unsigned a0 = cvt_pk_bf16(P[B_+0], P[B_+1]), a1 = cvt_pk_bf16(P[B_+2], P[B_+3]);                          \
        unsigned b0 = cvt_pk_bf16(P[B_+4], P[B_+5]), b1 = cvt_pk_bf16(P[B_+6], P[B_+7]);                                             \
        auto r0 = __builtin_amdgcn_permlane32_swap(a0, b0, false, false); auto r1 = __builtin_amdgcn_permlane32_swap(a1, b1, false, false); \
        u32x4 w = {r0[0], r1[0], r0[1], r1[1]}; OUT = *reinterpret_cast<bf16x8*>(&w); } while (0)
    PK4(p0, 0, pa0); PK4(p0, 8, pa1); PK4(p1, 0, pa2); PK4(p1, 8, pa3);
#undef PK4
}
template <int KB>
__device__ __forceinline__ void qkt(f32x16& p0, f32x16& p1, const char* K_lds, int r32, int hi, const char* ql, bool act) {
    if (!act) { const float NEG = -__builtin_inff();
#pragma unroll
        for (int r = 0; r < 16; ++r) { p0[r] = NEG; p1[r] = NEG; } return; }
    p0 = f32x16{}; p1 = f32x16{};
    const char* kb[4];
#pragma unroll
    for (int dd = 0; dd < 4; ++dd) kb[dd] = K_lds + KB * SHM_K + KSWZ(r32, (dd * 16 + hi * 8) * 2);
#pragma unroll
    for (int d0 = 0; d0 < 8; ++d0) { const char* a = kb[d0 & 3] + (d0 >> 2) * 128;
        bf16x8 b0 = *reinterpret_cast<const bf16x8*>(a);
        bf16x8 b1 = *reinterpret_cast<const bf16x8*>(a + 32 * 256);
        const bf16x8 qv = *reinterpret_cast<const bf16x8*>(ql + d0 * 1024);
        p0 = __builtin_amdgcn_mfma_f32_32x32x16_bf16(b0, qv, p0, 0, 0, 0);
        p1 = __builtin_amdgcn_mfma_f32_32x32x16_bf16(b1, qv, p1, 0, 0, 0); }
}
template <int VB>
__device__ __forceinline__ void pv_tile(f32x16* o, int vb0, bf16x8 pa0, bf16x8 pa1, bf16x8 pa2, bf16x8 pa3, bool act) {
    if (!act) return;
#define TRRD(dst, off) asm volatile("ds_read_b64_tr_b16 %0, %1 offset:%2" : "=&v"(dst) : "v"(vb0), "i"(off) : "memory")
#define PV_D0(d0) do { s16x4 l0, l1, l2, l3, h0, h1, h2, h3; constexpr int b_ = VB * SHM_V + v_rd_off(d0, 0, 0); \
        TRRD(l0, b_); TRRD(h0, b_ + 2048); TRRD(l1, b_ + 4096); TRRD(h1, b_ + 6144); TRRD(l2, b_ + 8192); TRRD(h2, b_ + 10240); TRRD(l3, b_ + 12288); TRRD(h3, b_ + 14336); \
        asm volatile("s_waitcnt lgkmcnt(0)" ::: "memory"); SBAR();   \
        o[d0] = __builtin_amdgcn_mfma_f32_32x32x16_bf16(pa0, (bf16x8){l0[0], l0[1], l0[2], l0[3], h0[0], h0[1], h0[2], h0[3]}, o[d0], 0, 0, 0);   \
        o[d0] = __builtin_amdgcn_mfma_f32_32x32x16_bf16(pa1, (bf16x8){l1[0], l1[1], l1[2], l1[3], h1[0], h1[1], h1[2], h1[3]}, o[d0], 0, 0, 0);   \
        o[d0] = __builtin_amdgcn_mfma_f32_32x32x16_bf16(pa2, (bf16x8){l2[0], l2[1], l2[2], l2[3], h2[0], h2[1], h2[2], h2[3]}, o[d0], 0, 0, 0);   \
        o[d0] = __builtin_amdgcn_mfma_f32_32x32x16_bf16(pa3, (bf16x8){l3[0], l3[1], l3[2], l3[3], h3[0], h3[1], h3[2], h3[3]}, o[d0], 0, 0, 0); } while (0)
    PV_D0(0); PV_D0(1); PV_D0(2); PV_D0(3);
#undef PV_D0
#undef TRRD
}
__device__ __forceinline__ int first_tile_above(const float* bb, float cut, int jmax, int lane) {
    const int stride = (jmax >> 6) + 1; int t1 = (lane + 1) * stride - 1; if (t1 > jmax) t1 = jmax;
    const unsigned long long m1 = __ballot(bb[t1 * 64] > cut); const int l1 = m1 ? (int)__builtin_ctzll(m1) : 63;
    const int base = l1 * stride; int t2 = base + (lane < stride ? lane : stride - 1); if (t2 > jmax) t2 = jmax;
    const unsigned long long m2 = __ballot(bb[t2 * 64] > cut); const int l2 = m2 ? (int)__builtin_ctzll(m2) : stride - 1;
    int jl = base + l2; if (jl > jmax) jl = jmax; return __builtin_amdgcn_readfirstlane(jl); }
struct Bases { const bf16_t* Q; const bf16_t* K; const bf16_t* V; const bf16_t* G; const float* B; bf16_t* O; float thr2; };
struct BlockRef { unsigned qo, ko, bo; float bref; int P0, jlo, jhi, nvw; };
struct Seam { bf16x8 st_v0, st_v1, st_k0, st_k1; float st_b; };
#define ROWP(p, k0, rr) ((const bf16_t*)((const char*)((p) + (size_t)(k0) * PITCH) + (unsigned)(((rr) * PITCH + sc) * 2)))
#define VMW() asm volatile("s_waitcnt vmcnt(0)" ::: "memory")
#define VMWN(n) asm volatile("s_waitcnt vmcnt(%0)" :: "i"(n) : "memory")
#define SLOAD_H(R_, k0) do { S.st_v0 = load8(ROWP(BS.V + (R_).ko, k0, sr)); S.st_v1 = load8(ROWP(BS.V + (R_).ko, k0, 32 + sr));              \
                         S.st_k0 = load8(ROWP(BS.K + (R_).ko, k0, sr)); S.st_k1 = load8(ROWP(BS.K + (R_).ko, k0, 32 + sr)); if (tid < 64) S.st_b = (BS.B + (R_).bo)[(k0) + tid] - (R_).bref; } while (0)
#define SWRITE_HK(bf) do { *(bf16x8*)(K_lds + (bf) * SHM_K + kws) = S.st_k0; *(bf16x8*)(K_lds + (bf) * SHM_K + kws + 32 * 256) = S.st_k1; if (tid < 64) B_lds[(bf) * 64 + tid] = S.st_b; } while (0)
#define SWRITE_HV(bf) do { *(bf16x8*)(V_lds + (bf) * SHM_V + vst0) = S.st_v0; *(bf16x8*)(V_lds + (bf) * SHM_V + vst1) = S.st_v1; } while (0)
#define SWRITE_H(bf) do { SWRITE_HV(bf); SWRITE_HK(bf); } while (0)
__device__ __forceinline__ void attn_prime(const Bases& BS, const BlockRef& cur, char* lds, Seam& S, const int wid) {
    const int lane = lane_id_opaque(), tid = wid * 64 + lane, r32 = lane & 31, hi = lane >> 5;
    const int sr = tid >> 4, sc = (tid & 15) * 8, kws = KSWZ(sr, sc * 2); char* K_lds = lds + OFF_K; float* B_lds = (float*)(lds + OFF_B);
    { char* ql = lds + OFF_QL + wid * 8192 + lane * 16; const bf16_t* qn = BS.Q + cur.qo + (size_t)(wid * QBLK + r32) * PITCH + hi * 8; bf16x8 tq[8];
#pragma unroll
      for (int d0 = 0; d0 < 8; ++d0) tq[d0] = load8(qn + d0 * 16);
#pragma unroll
      for (int d0 = 0; d0 < 8; ++d0) *reinterpret_cast<bf16x8*>(ql + d0 * 1024) = tq[d0]; }
    SLOAD_H(cur, (cur.jhi - 1) * KVBLK); VMW(); SWRITE_HK(0);
    __syncthreads();
}
__device__ __forceinline__ void attn_block(const Bases& BS, const BlockRef& cur, const BlockRef& nxt, char* lds, Seam& S, const int wid) {
    const int lane = lane_id_opaque(), tid = wid * 64 + lane, r32 = lane & 31, hi = lane >> 5;
    const int j_hi = cur.jhi; int NT = cur.jhi - cur.jlo, jlw = 0;
    const int qlo = cur.P0 + wid * QBLK, qm = qlo + r32 - 4 * hi;
    char* V_lds = lds; char* K_lds = lds + OFF_K; float* B_lds = (float*)(lds + OFF_B);
    float* ws = (float*)(lds + OFF_WS) + wid * 64; float* li_l = ws, * al_l = ws + 32;
    float m_reg = -1e30f, l_reg = 0; f32x16 o[4] = {};
    const int sr = tid >> 4, sc = (tid & 15) * 8, vst0 = v_st(sr, sc), vst1 = v_st(32 + sr, sc), kws = KSWZ(sr, sc * 2);
    const int vb0 = (int)(uintptr_t)V_lds + v_rd_base(lane);
    const char* ql = lds + OFF_QL + wid * 8192 + lane * 16;
#define RESC(a) do { if (__any((a) < 1.f)) { if (hi == 0) al_l[r32] = (a); asm volatile("s_waitcnt lgkmcnt(0)" ::: "memory");              \
                     for (int d_ = 0; d_ < 4; ++d_) for (int r = 0; r < 16; ++r) o[d_][r] *= al_l[crow(r, hi)]; } } while (0)
#define KBASE(t) ((j_hi - 1 - (t)) * KVBLK)
#define ACT(t) (wid < cur.nvw && KBASE(t) <= qlo + QBLK - 1 && j_hi - 1 - (t) >= jlw)
#define MASKT(P0_, P1_, t) do { const int kb_ = KBASE(t); if (ACT(t) && kb_ + KVBLK - 1 > qlo) mask_tile(P0_, P1_, qm - kb_); } while (0)
    f32x16 pA0, pA1, pB0, pB1; float mnA, mnB, alA, alB; bf16x8 pa0, pa1, pa2, pa3;
    SWRITE_HV(0); SBAR();
    if (NT > 1) SLOAD_H(cur, KBASE(1));
    SBAR(); qkt<0>(pA0, pA1, K_lds, r32, hi, ql, ACT(0));
    MASKT(pA0, pA1, 0); partialSM(pA0, pA1, m_reg, mnA, alA, B_lds, hi);
    if (NT > 1) { VMW(); SWRITE_H(1); }
    __syncthreads();
#define HALF_STEP(PX0, PX1, mnX, alX, PY0, PY1, alY, t, KB, VB, SB) do {                                                      \
        SBAR(); qkt<KB>(PX0, PX1, K_lds, r32, hi, ql, ACT(t));                                                         \
        finishSM(PY0, PY1, alY, l_reg, pa0, pa1, pa2, pa3); SBAR();                                                           \
        if ((t) + 1 < NT) { SLOAD_H(cur, KBASE((t) + 1)); SBAR(); }                                                           \
        pv_tile<VB>(o, vb0, pa0, pa1, pa2, pa3, ACT((t) - 1)); MASKT(PX0, PX1, (t)); partialSM(PX0, PX1, m_reg, mnX, alX, B_lds + (KB) * 64, hi);   \
        __syncthreads();                                                                                                      \
        if ((t) + 1 < NT) { VMW(); SWRITE_H(SB); }                                                                            \
        RESC(alX); __syncthreads(); } while (0)
    int t = 1;
    for (; t + 1 < NT && t < 5; t += 2) {
        HALF_STEP(pB0, pB1, mnB, alB, pA0, pA1, alA, t, 1, 0, 0);
        HALF_STEP(pA0, pA1, mnA, alA, pB0, pB1, alB, t + 1, 0, 1, 1);
    }
    if (t == 5 && cur.nvw == NW && NT > 7) {
        float mv = m_reg > -1e29f ? m_reg : 3e38f;
#pragma unroll
        for (int o_ = 1; o_ < 64; o_ <<= 1) mv = fminf(mv, __shfl_xor(mv, o_));
        float* mm = (float*)(lds + OFF_Q + 16);
        if (lane == 0) mm[wid] = mv;
        asm volatile("s_waitcnt lgkmcnt(0)" ::: "memory"); __syncthreads();
        float mmin = mm[0];
#pragma unroll
        for (int w_ = 1; w_ < NW; ++w_) mmin = fminf(mmin, mm[w_]);
        if (mmin < 1e38f) { const int p1 = cur.P0 > 0 ? cur.P0 : 0; int jl = first_tile_above(BS.B + cur.bo + 63, cur.bref - (BS.thr2 - mmin), p1 >> 6, lane);
            if (jl < cur.jlo) jl = cur.jlo; int ntn = j_hi - jl; if (ntn < 5) ntn = 5; if (ntn < NT) NT = ntn;
            if (mv < 1e38f) jlw = first_tile_above(BS.B + cur.bo + 63, cur.bref - (BS.thr2 - mv), p1 >> 6, lane); }
    }
    for (; t + 1 < NT; t += 2) {
        HALF_STEP(pB0, pB1, mnB, alB, pA0, pA1, alA, t, 1, 0, 0);
        HALF_STEP(pA0, pA1, mnA, alA, pB0, pB1, alB, t + 1, 0, 1, 1);
    }
    const bool even = (NT & 1) == 0;
    if (even) { SBAR(); qkt<1>(pB0, pB1, K_lds, r32, hi, ql, ACT(NT - 1)); SBAR(); }
    { const int ozt = opaque_zero(); const int sr = (tid >> 4) + ozt, sc = (tid & 15) * 8;
      SLOAD_H(nxt, (nxt.jhi - 1) * KVBLK); }
    SBAR();
    finishSM(pA0, pA1, alA, l_reg, pa0, pa1, pa2, pa3); SBAR();
    pv_tile<0>(o, vb0, pa0, pa1, pa2, pa3, ACT(even ? NT - 2 : NT - 1));
    if (even) { MASKT(pB0, pB1, NT - 1); partialSM(pB0, pB1, m_reg, mnB, alB, B_lds + 64, hi); __syncthreads(); RESC(alB);
        finishSM(pB0, pB1, alB, l_reg, pa0, pa1, pa2, pa3); SBAR(); pv_tile<1>(o, vb0, pa0, pa1, pa2, pa3, ACT(NT - 1)); }
    SBAR(); VMW(); SWRITE_HK(0); SBAR();
    if (hi == 0) li_l[r32] = l_reg; asm volatile("s_waitcnt lgkmcnt(0)" ::: "memory");
    float rli[16];
#pragma unroll
    for (int r = 0; r < 16; ++r) { const float lv = li_l[crow(r, hi)]; rli[r] = lv > 0.f ? __builtin_amdgcn_rcpf(lv) : 0.f; }
    const int ozq = opaque_zero(); bf16x8 tq[8];
    { const bf16_t* qn = BS.Q + nxt.qo + (size_t)(wid * QBLK + r32 + ozq) * PITCH + hi * 8;
#pragma unroll
      for (int d0 = 0; d0 < 8; ++d0) tq[d0] = load8(qn + d0 * 16); }
    if (wid < cur.nvw) {
        const int oz = opaque_zero(); bf16_t* Ow = BS.O + cur.qo + (size_t)(wid * QBLK) * PITCH + oz; const bf16_t* Gw = BS.G + cur.qo + (size_t)(wid * QBLK) * PITCH + oz;
        float* tl = (float*)(lds + OFF_QL + wid * 8192);
#pragma unroll
        for (int ps = 0; ps < 2; ++ps) {
#pragma unroll
            for (int rr = 0; rr < 8; ++rr) { const int r = ps * 8 + rr, lrow = (rr & 3) + 8 * (rr >> 2) + 4 * hi;
#pragma unroll
                for (int d0 = 0; d0 < 4; ++d0) tl[lrow * 128 + d0 * 32 + r32] = o[d0][r] * rli[r]; }
            asm volatile("s_waitcnt lgkmcnt(0)" ::: "memory");
#pragma unroll
            for (int it = 0; it < 4; ++it) { const int ch = it * 64 + lane, lrow = ch >> 4, c8 = (ch & 15) * 8; const size_t go = (size_t)(16 * ps + lrow) * PITCH + c8;
                const f32x4 a = *(const f32x4*)(tl + lrow * 128 + c8), b = *(const f32x4*)(tl + lrow * 128 + c8 + 4);
                const u32x4 gv = *(const u32x4*)(Gw + go);
                f32x4 g0, g1; g0[0] = __uint_as_float(gv[0] << 16); g0[1] = __uint_as_float(gv[0] & 0xffff0000u); g0[2] = __uint_as_float(gv[1] << 16); g0[3] = __uint_as_float(gv[1] & 0xffff0000u);
                g1[0] = __uint_as_float(gv[2] << 16); g1[1] = __uint_as_float(gv[2] & 0xffff0000u); g1[2] = __uint_as_float(gv[3] << 16); g1[3] = __uint_as_float(gv[3] & 0xffff0000u);
                const f32x4 y0 = a * g0, y1 = b * g1; u32x4 w; w.x = cvt_pk_bf16(y0[0], y0[1]); w.y = cvt_pk_bf16(y0[2], y0[3]); w.z = cvt_pk_bf16(y1[0], y1[1]); w.w = cvt_pk_bf16(y1[2], y1[3]);
                *(u32x4*)(Ow + go) = w; }
            asm volatile("s_waitcnt lgkmcnt(0)" ::: "memory");
        }
    }
    { char* qlw = lds + OFF_QL + wid * 8192 + (lane + ozq) * 16;
#pragma unroll
      for (int d0 = 0; d0 < 8; ++d0) *reinterpret_cast<bf16x8*>(qlw + d0 * 1024) = tq[d0]; }
    __syncthreads();
#undef RESC
#undef KBASE
#undef MASKT
#undef ACT
#undef HALF_STEP
}
#undef ROWP
#undef VMW
#undef VMWN
#undef SLOAD_H
#undef SWRITE_HK
#undef SWRITE_HV
#undef SWRITE_H
}
constexpr size_t MiB = (size_t)1 << 20;
constexpr size_t WS_CTL = 0, CTL_ZERO_BYTES = 128 * 1024;
constexpr size_t WS_COS = 2 * MiB, WS_SIN = 11 * MiB, WS_BP = 20 * MiB, WS_BS = WS_BP + (size_t)HF * BP_LEN * 4, WS_LF = 24 * MiB;
constexpr size_t SZ_WFI = (size_t)8448 * DM * 2, SZ_WFO = (size_t)DM * DM * 2, SZ_WRI = (size_t)NRETIN * DM * 2, SZ_WRO = (size_t)DM * DVT * 2, SZ_WUP = (size_t)DFF * DM * 2, SZ_WDN = (size_t)DM * DFFP * 2;
constexpr size_t WS_WFI = 32 * MiB, WS_WFO = WS_WFI + 2 * SZ_WFI, WS_WRI = WS_WFO + 2 * SZ_WFO, WS_WRO = WS_WRI + 2 * SZ_WRI, WS_WUP = WS_WRO + 2 * SZ_WRO, WS_WDN = WS_WUP + 4 * SZ_WUP, WS_WEND = WS_WDN + 4 * SZ_WDN;
static_assert(WS_WEND <= 500 * MiB, "weights map");
constexpr size_t WS_H = 500 * MiB, WS_XN = 638 * MiB, WS_R = 708 * MiB;
constexpr size_t R_Q = WS_R, R_K = WS_R + 70 * MiB, R_V = WS_R + 204 * MiB, R_G = WS_R + 338 * MiB;
constexpr size_t R_U = WS_R;
constexpr size_t R_SG = WS_R, R_AP = WS_R + 138 * MiB, R_BT = WS_R + 276 * MiB, R_KRN = WS_R + 536 * MiB, R_KTP = WS_R + 605 * MiB, R_OB = R_KRN, R_APS = WS_R + 674 * MiB, R_BTS = WS_R + 694 * MiB, R_KTS = WS_R + 734 * MiB;
constexpr size_t WS_SLAB = WS_R + 750 * MiB, WS_END = WS_SLAB + 64 * MiB;
static_assert((size_t)NSLAB * SLAB_ROWS * DM * 4 <= 64 * MiB, "slab");
static_assert((size_t)MROWS * DM * 4 <= 138 * MiB && (size_t)KB_ROWS * DM * 2 <= 134 * MiB && (size_t)8 * 65 * 512 * 512 * 2 <= 260 * MiB && (size_t)MROWS * DFFP * 2 <= 280 * MiB, "ws sizes");
constexpr int CW_BAR = 4096, CW_ATTN = 16384, CW_SCAN = 20480;

constexpr int RING_BYTES = 131072, XL_OFF = RING_BYTES  , MISC_OFF = RING_BYTES + 8192, LDS_BYTES = 147456;

#define RLX_AGENT __ATOMIC_RELAXED, __HIP_MEMORY_SCOPE_AGENT
#define LDS_WAIT() asm volatile("s_waitcnt lgkmcnt(0)" ::: "memory")
#define VM_WAIT() asm volatile("s_waitcnt vmcnt(0)" ::: "memory")

#define XB_TMO      128
#define XB_XCNT(j)  (256  + 64 * (j))
#define XB_XSUB(j)  (1280 + 64 * (j))
#define XB_XGEN(j)  (2304 + 64 * (j))
#define XB_TOP      3328
#define XB_TOPGEN   3392
#define XCD_BAR_WORDS 3456
#define XB_SPIN_CAP (1u << 20)
__device__ __forceinline__ unsigned xb_ld(unsigned* p)              { return __hip_atomic_load(p, __ATOMIC_RELAXED, __HIP_MEMORY_SCOPE_AGENT); }
__device__ __forceinline__ unsigned xb_add(unsigned* p, unsigned v) { return __hip_atomic_fetch_add(p, v, __ATOMIC_RELAXED, __HIP_MEMORY_SCOPE_AGENT); }
__device__ __forceinline__ unsigned xb_xcc_id() { return (unsigned)__builtin_amdgcn_s_getreg((3 << 11) | 20) & 0xFu; }
#define XB_SPIN(cond, bar) do { unsigned _sp = 0; while (cond) { __builtin_amdgcn_s_sleep(1); \
    if ((++_sp & 255u) == 0u) { if (xb_ld(&(bar)[XB_TMO])) break; if (_sp > XB_SPIN_CAP) { atomicAdd(&(bar)[XB_TMO], 1u); break; } } } } while (0)
struct XcdBarrier { unsigned* bar; unsigned x; volatile LAS unsigned* st; };
__device__ __forceinline__ XcdBarrier xcd_barrier_post(unsigned* bar, volatile LAS unsigned* st, const bool t0) {
    XcdBarrier b; b.bar = bar; b.x = xb_xcc_id(); b.st = st;
    if (t0) (void)xb_add(&bar[XB_XCNT(b.x)], 1u);
    return b;
}
__device__ __forceinline__ void xcd_barrier_complete(unsigned* bar, unsigned x, unsigned& nloc, unsigned& nx) {
    const unsigned G = gridDim.x * gridDim.y * gridDim.z;
    unsigned sum, cnt, mine, sp = 0u;
    for (;;) {
        sum = 0u; cnt = 0u; mine = 0u;
#pragma unroll
        for (unsigned j = 0; j < 16; ++j) { const unsigned c = xb_ld(&bar[XB_XCNT(j)]); sum += c; cnt += (c > 0u) ? 1u : 0u; mine = (j == x) ? c : mine; }
        if (sum == G) break;
        __builtin_amdgcn_s_sleep(1);
        if ((++sp & 255u) == 0u) { if (xb_ld(&bar[XB_TMO])) break; if (sp > XB_SPIN_CAP) { atomicAdd(&bar[XB_TMO], 1u); break; } }
    }
    nloc = mine > 0u ? mine : 1u; nx = cnt > 0u ? cnt : 1u;
}
__device__ __forceinline__ void xcd_barrier(const XcdBarrier& b, const bool t0) {
    asm volatile("s_waitcnt vmcnt(0)" ::: "memory");
    __syncthreads();
    if (t0) {
        unsigned* bar = b.bar;
        __builtin_amdgcn_s_waitcnt(0);
        unsigned nloc = b.st[0], nx = b.st[1];
        if (nloc == 0u) { xcd_barrier_complete(bar, b.x, nloc, nx); b.st[0] = nloc; b.st[1] = nx; }
        const unsigned old = xb_add(&bar[XB_XSUB(b.x)], 1u);
        const unsigned gen = old / nloc;
        if (old + 1u == (gen + 1u) * nloc) {
            __builtin_amdgcn_fence(__ATOMIC_RELEASE, "agent");
            asm volatile("s_waitcnt vmcnt(0)" ::: "memory");
            const unsigned og = xb_add(&bar[XB_TOP], 1u);
            const unsigned tg = og / nx;
            if (og + 1u == (tg + 1u) * nx) xb_add(&bar[XB_TOPGEN], 1u);
            else XB_SPIN(xb_ld(&bar[XB_TOPGEN]) == tg, bar);
            __builtin_amdgcn_fence(__ATOMIC_ACQUIRE, "agent");
            xb_add(&bar[XB_XGEN(b.x)], 1u);
            asm volatile("s_waitcnt vmcnt(0)" ::: "memory");
        } else {
            XB_SPIN(xb_ld(&bar[XB_XGEN(b.x)]) == gen, bar);
            __builtin_amdgcn_fence(__ATOMIC_ACQUIRE, "agent");
            asm volatile("s_waitcnt vmcnt(0)" ::: "memory");
        }
    }
    __syncthreads();
}

#define NORM_ROWS(body) do { \
    if (ngw == 2048 && slab) { \
        if (gw < SLAB_ROWS) { { const int row = SLAB_ROW0 + gw; body } for (int row = gw; row < 7 * SLAB_ROWS; row += SLAB_ROWS) { body } } \
        else for (int row = 7 * SLAB_ROWS + (gw - SLAB_ROWS); row < SLAB_ROW0; row += 2048 - SLAB_ROWS) { body } \
    } else for (int row = gw; row < MROWS; row += ngw) { body } } while (0)
__device__ __forceinline__ void norm_rows_bf16(float* h, const float* gain, bf16_t* xn, const float* slab, int gw, int ngw) {
    const int lane = lane_id_opaque();
    f32x4 gv[8];
#pragma unroll
    for (int j = 0; j < 8; ++j) gv[j] = ((const f32x4*)gain)[lane + 64 * j];
    NORM_ROWS({
        f32x4* xr = (f32x4*)(h + (size_t)row * DM) + lane; f32x4 v[8]; float s = 0.f;
        _Pragma("unroll") for (int j = 0; j < 8; ++j) v[j] = xr[64 * j];
        if (slab && row >= SLAB_ROW0) {
            _Pragma("unroll") for (int p = 0; p < NSLAB; ++p) { const u32x2* sr = (const u32x2*)((const bf16_t*)slab + ((size_t)p * SLAB_ROWS + (row - SLAB_ROW0)) * DM) + lane;
                _Pragma("unroll") for (int j = 0; j < 8; ++j) { const u32x2 w = sr[64 * j]; v[j][0] += __uint_as_float(w.x << 16); v[j][1] += __uint_as_float(w.x & 0xffff0000u); v[j][2] += __uint_as_float(w.y << 16); v[j][3] += __uint_as_float(w.y & 0xffff0000u); } }
            _Pragma("unroll") for (int j = 0; j < 8; ++j) xr[64 * j] = v[j];
        }
        _Pragma("unroll") for (int j = 0; j < 8; ++j) s += (v[j][0] * v[j][0] + v[j][1] * v[j][1]) + (v[j][2] * v[j][2] + v[j][3] * v[j][3]);
        const float rs = 1.0f / sqrtf(wave_sum(s) * (1.0f / DM) + EPS);
        u32x2* o = (u32x2*)(xn + (size_t)row * DM) + lane;
        _Pragma("unroll") for (int j = 0; j < 8; ++j) { const f32x4 y = v[j] * rs * gv[j]; u32x2 w; w.x = cvt_pk_bf16(y[0], y[1]); w.y = cvt_pk_bf16(y[2], y[3]); o[64 * j] = w; }
    });
}
__device__ __forceinline__ void norm_rows_out(const float* h, const float* gain, float* out, const float* slab, int gw, int ngw) {
    const int lane = lane_id_opaque();
    f32x4 gv[8];
#pragma unroll
    for (int j = 0; j < 8; ++j) gv[j] = ((const f32x4*)gain)[lane + 64 * j];
    NORM_ROWS({
        if (!(row >= ROW_PAD && row < ROW_P0 + NMETA)) {
        float* dst = row < ROW_PAD ? out + O_YS + (size_t)row * DM : out + O_YP + (size_t)(row - ROW_P0 - NMETA) * DM;
        const f32x4* xr = (const f32x4*)(h + (size_t)row * DM) + lane; f32x4 v[8]; float s = 0.f;
        _Pragma("unroll") for (int j = 0; j < 8; ++j) v[j] = xr[64 * j];
        if (row >= SLAB_ROW0) {
            _Pragma("unroll") for (int p = 0; p < NSLAB; ++p) { const u32x2* sr = (const u32x2*)((const bf16_t*)slab + ((size_t)p * SLAB_ROWS + (row - SLAB_ROW0)) * DM) + lane;
                _Pragma("unroll") for (int j = 0; j < 8; ++j) { const u32x2 w = sr[64 * j]; v[j][0] += __uint_as_float(w.x << 16); v[j][1] += __uint_as_float(w.x & 0xffff0000u); v[j][2] += __uint_as_float(w.y << 16); v[j][3] += __uint_as_float(w.y & 0xffff0000u); } }
        }
        _Pragma("unroll") for (int j = 0; j < 8; ++j) s += (v[j][0] * v[j][0] + v[j][1] * v[j][1]) + (v[j][2] * v[j][2] + v[j][3] * v[j][3]);
        const float rs = 1.0f / sqrtf(wave_sum(s) * (1.0f / DM) + EPS);
        _Pragma("unroll") for (int j = 0; j < 8; ++j) ((f32x4*)dst)[lane + 64 * j] = v[j] * rs * gv[j];
        }
    });
}
__device__ __forceinline__ void transpose_item(const float* W, int ldw, int nblk, bf16_t* WT, int ldt, LAS float* scr, int item, int lane) {
    const int kb = item / nblk, nb = item % nblk, k0 = 64 * kb, n0 = 32 * nb;
    f32x4 t[8];
#pragma unroll
    for (int i = 0; i < 8; ++i) t[i] = *(const f32x4*)(W + (size_t)(k0 + 8 * i + (lane >> 3)) * ldw + n0 + 4 * (lane & 7));
#pragma unroll
    for (int i = 0; i < 8; ++i) { LAS float* d = scr + (8 * i + (lane >> 3)) * 33 + 4 * (lane & 7); d[0] = t[i][0]; d[1] = t[i][1]; d[2] = t[i][2]; d[3] = t[i][3]; }
    LDS_WAIT(); asm volatile("" ::: "memory");
    const int c = lane & 7;
#pragma unroll
    for (int j = 0; j < 4; ++j) { const int n = (lane >> 3) + 8 * j; const LAS float* s = scr + (8 * c) * 33 + n;
        u32x4 o; o.x = cvt_pk_bf16(s[0 * 33], s[1 * 33]); o.y = cvt_pk_bf16(s[2 * 33], s[3 * 33]); o.z = cvt_pk_bf16(s[4 * 33], s[5 * 33]); o.w = cvt_pk_bf16(s[6 * 33], s[7 * 33]);
        *(u32x4*)(WT + (size_t)(n0 + n) * ldt + k0 + 8 * c) = o; }
    LDS_WAIT(); asm volatile("" ::: "memory");
}
__device__ __forceinline__ void sincos_d(double a, float& sv, float& cv) {
    const double n = __builtin_rint(a * 0.63661977236758134308);
    double r = __builtin_fma(-n, 1.57079632679489655800e+00, a); r = __builtin_fma(-n, 6.12323399573676603587e-17, r);
    const double z = r * r;
    const double sp = r * (1.0 + z * (-1.0 / 6 + z * (1.0 / 120 + z * (-1.0 / 5040 + z * (1.0 / 362880 + z * (-1.0 / 39916800 + z * (1.0 / 6227020800.0)))))));
    const double cp = 1.0 + z * (-0.5 + z * (1.0 / 24 + z * (-1.0 / 720 + z * (1.0 / 40320 + z * (-1.0 / 3628800 + z * (1.0 / 479001600 + z * (-1.0 / 87178291200.0)))))));
    const int q = ((int)(long long)n) & 3;
    const double s = (q & 1) ? cp : sp, c = (q & 1) ? sp : cp;
    sv = (float)((q & 2) ? -s : s); cv = (float)(((q + 1) & 2) ? -c : c);
}
__device__ __forceinline__ void prologue_phase(const float* const* in, unsigned char* ws, LAS unsigned char* lds, int gw, int ngw, int wave) {
    const int lane = lane_id_opaque();
    LAS float* scr = (LAS float*)(lds + wave * 16384);
    constexpr int I_FI = 32 * 256, I_FO = 32 * 64, I_RI = 32 * 384, I_RO = 64 * 64, I_UP = 32 * 256, I_DN = 128 * 64;
    constexpr int NITEMS = 2 * I_FI + 2 * I_FO + 2 * I_RI + 2 * I_RO + 4 * I_UP + 4 * I_DN;
    for (int it = gw; it < NITEMS; it += ngw) {
        int r = it;
        if (r < 2 * I_FI) { const int j = r / I_FI; transpose_item(in[10] + (size_t)j * DM * NFOXIN, NFOXIN, 256, (bf16_t*)(ws + WS_WFI + j * SZ_WFI), DM, scr, r % I_FI, lane); continue; } r -= 2 * I_FI;
        if (r < 2 * I_FO) { const int j = r / I_FO; transpose_item(in[14] + (size_t)j * DM * DM, DM, 64, (bf16_t*)(ws + WS_WFO + j * SZ_WFO), DM, scr, r % I_FO, lane); continue; } r -= 2 * I_FO;
        if (r < 2 * I_RI) { const int j = r / I_RI; transpose_item(in[15] + (size_t)j * DM * NRETIN, NRETIN, 384, (bf16_t*)(ws + WS_WRI + j * SZ_WRI), DM, scr, r % I_RI, lane); continue; } r -= 2 * I_RI;
        if (r < 2 * I_RO) { const int j = r / I_RO; transpose_item(in[17] + (size_t)j * DVT * DM, DM, 64, (bf16_t*)(ws + WS_WRO + j * SZ_WRO), DVT, scr, r % I_RO, lane); continue; } r -= 2 * I_RO;
        if (r < 4 * I_UP) { const int l = r / I_UP; transpose_item(in[18] + (size_t)l * DM * DFF, DFF, 256, (bf16_t*)(ws + WS_WUP + l * SZ_WUP), DM, scr, r % I_UP, lane); continue; } r -= 4 * I_UP;
        { const int l = r / I_DN; transpose_item(in[19] + (size_t)l * DFF * DM, DM, 64, (bf16_t*)(ws + WS_WDN + l * SZ_WDN), DFFP, scr, r % I_DN, lane); }
    }
    const int gt = gw * 64 + lane, ngt = ngw * 64;
    for (int e = gt; e < 2 * 16 * DM; e += ngt) { const int j = e / (16 * DM), c = (e / DM) & 15, k = e % DM;
        ((bf16_t*)(ws + WS_WFI + j * SZ_WFI))[(size_t)(8192 + c) * DM + k] = (bf16_t)(cvt_pk_bf16(in[10][(size_t)j * DM * NFOXIN + (size_t)k * NFOXIN + 8192 + c], 0.f) & 0xffffu); }
    for (int e = gt; e < 2 * 240 * DM / 8; e += ngt) { const int j = e / (240 * DM / 8), o = e % (240 * DM / 8);
        ((u32x4*)(ws + WS_WFI + j * SZ_WFI + (size_t)8208 * DM * 2))[o] = (u32x4){0u, 0u, 0u, 0u}; }
    float* h = (float*)(ws + WS_H); bf16_t* xn = (bf16_t*)(ws + WS_XN);
    { f32x4 gv[8];
#pragma unroll
      for (int j = 0; j < 8; ++j) gv[j] = ((const f32x4*)in[7])[lane + 64 * j];
      for (int row = gw; row < MROWS; row += ngw) { f32x4* d = (f32x4*)(h + (size_t)row * DM) + lane;
        const float* s = row < ROW_PAD ? in[1] + (size_t)row * DM : (row < ROW_P0 ? nullptr : (row < ROW_P0 + NMETA ? in[6] + (size_t)(row - ROW_P0) * DM : in[0] + (size_t)(row - ROW_P0 - NMETA) * DM));
        f32x4 v[8]; float ss = 0.f;
#pragma unroll
        for (int j = 0; j < 8; ++j) { v[j] = s ? ((const f32x4*)s)[lane + 64 * j] : (f32x4){0.f, 0.f, 0.f, 0.f}; d[64 * j] = v[j];
            ss += (v[j][0] * v[j][0] + v[j][1] * v[j][1]) + (v[j][2] * v[j][2] + v[j][3] * v[j][3]); }
        const float rs = 1.0f / sqrtf(wave_sum(ss) * (1.0f / DM) + EPS);
        u32x2* o = (u32x2*)(xn + (size_t)row * DM) + lane;
#pragma unroll
        for (int j = 0; j < 8; ++j) { const f32x4 y = v[j] * rs * gv[j]; u32x2 w; w.x = cvt_pk_bf16(y[0], y[1]); w.y = cvt_pk_bf16(y[2], y[3]); o[64 * j] = w; } } }
    float* COS = (float*)(ws + WS_COS); float* SIN = (float*)(ws + WS_SIN);
    for (int e = gt; e < LP * 128; e += ngt) { const int pos = e >> 7, c = e & 127;
        const float inv = (float)exp2(-(double)c * (13.287712379549449 / 128.0)); const float ang = (float)pos * inv; float sv, cv; sincos_d((double)ang, sv, cv);
        COS[e] = cv; SIN[e] = sv; }
}
__device__ __forceinline__ void fox_cache_phase(const float* ck, const float* cv, bf16_t* kbuf, bf16_t* vbuf, int gw, int ngw, bool convert) {
    const int lane = lane_id_opaque();
    if (convert) for (int t = gw; t < 2 * DB * PAST; t += ngw) { const int which = t >= DB * PAST, r = which ? t - DB * PAST : t;
        const f32x4* s = (const f32x4*)((which ? cv : ck) + (size_t)r * DM) + lane; u32x2* d = (u32x2*)((which ? vbuf : kbuf) + ((size_t)(r >> 10) * SKS + (r & 1023)) * DM) + lane;
#pragma unroll
        for (int j = 0; j < 8; ++j) { const f32x4 y = s[64 * j]; u32x2 w; w.x = cvt_pk_bf16(y[0], y[1]); w.y = cvt_pk_bf16(y[2], y[3]); d[64 * j] = w; } }
    for (int t = gw; t < 2 * 48; t += ngw) { u32x2* d = (u32x2*)((t >= 48 ? vbuf : kbuf) + (size_t)(KB_ROWS - 48 + (t % 48)) * DM) + lane;
#pragma unroll
        for (int j = 0; j < 8; ++j) d[64 * j] = (u32x2){0u, 0u}; }
}
__device__ __forceinline__ void scan_job(int wg, const float* lf, const float* clf, float* bP, float* bS, LAS double* sums, int wave) {
    const int lane = lane_id_opaque(), tid = wave * 64 + lane;
    constexpr double L2E = 1.4426950408889634;
    if (wg < 16) {
        const int head = wg, p0 = tid * 33; float v[33]; double s = 0.0;
#pragma unroll
        for (int i = 0; i < 33; ++i) { const int p = p0 + i; v[i] = p < LP ? lf[(size_t)(ROW_P0 + p) * HF + head] : 0.f; }
#pragma unroll
        for (int i = 0; i < 33; ++i) s += (double)v[i];
        double inc = s;
#pragma unroll
        for (int o = 1; o < 64; o <<= 1) { const double t = __shfl_up(inc, o); if (lane >= o) inc += t; }
        if (lane == 63) sums[wave] = inc;
        LDS_WAIT(); __syncthreads();
        double run = inc - s;
        for (int w = 0; w < wave; ++w) run += sums[w];
        float* out = bP + (size_t)head * BP_LEN;
#pragma unroll
        for (int i = 0; i < 33; ++i) { const int p = p0 + i; run += (double)v[i]; if (p < LP) out[p] = (float)(-run * L2E); }
        if (tid < BP_LEN - LP) out[LP + tid] = 0.f;
    } else {
        const int b = wg - 16, head = tid & 15, ck = tid >> 4, p0 = ck * 34; float v[34]; double s = 0.0;
#pragma unroll
        for (int i = 0; i < 34; ++i) { const int p = p0 + i; v[i] = p < PAST ? clf[((size_t)b * PAST + p) * HF + head] : lf[(size_t)(b * DS + p - PAST) * HF + head]; }
#pragma unroll
        for (int i = 0; i < 34; ++i) s += (double)v[i];
        sums[ck * 16 + head] = s;
        LDS_WAIT(); __syncthreads();
        double run = 0.0;
        for (int c = 0; c < ck; ++c) run += sums[c * 16 + head];
        float* out = bS + ((size_t)b * HF + head) * SKS;
#pragma unroll
        for (int i = 0; i < 34; ++i) { run += (double)v[i]; out[p0 + i] = (float)(-run * L2E); }
    }
}
__device__ __forceinline__ void scan_phase(const float* lf, const float* clf, float* bP, float* bS, LAS unsigned char* lds, int wave) {
    if ((int)blockIdx.x < 32) scan_job((int)blockIdx.x, lf, clf, bP, bS, (LAS double*)lds, wave);
}
#ifndef FA_CUT_BITS
#define FA_CUT_BITS 68
#endif
constexpr float FA_CUT = (float)FA_CUT_BITS + 2.0f;
__device__ __forceinline__ fa::BlockRef fa_ref(int item, const float* B, float thr, int lane) {
    fa::BlockRef r;
    if (item < 65 * HF) { const int blk = 64 - item / HF, head = item & 15;
        r.qo = (unsigned)((ROW_PAD + 256 * blk) * DM + head * DHF); r.ko = (unsigned)(KB_PROMPT0 * DM + head * DHF); r.bo = (unsigned)(head * BP_LEN);
        r.P0 = -240 + 256 * blk; const int p1 = r.P0 > 0 ? r.P0 : 0; r.bref = B[r.bo + p1]; r.jhi = (r.P0 + 255) / 64 + 1; r.nvw = 8;
        r.jlo = fa::first_tile_above(B + r.bo + 63, r.bref - thr, p1 >> 6, lane); }
    else { const int s = item - 65 * HF, b = s >> 4, head = s & 15;
        r.qo = (unsigned)((b * DS) * DM + head * DHF); r.ko = (unsigned)((b * SKS) * DM + head * DHF); r.bo = (unsigned)(HF * BP_LEN + (b * HF + head) * SKS);
        r.P0 = PAST; r.bref = B[r.bo + PAST]; r.jlo = 0; r.jhi = SKS / 64; r.nvw = 2; }
    return r;
}
__device__ __forceinline__ void attn_phase(unsigned* head_word, const bf16_t* qbuf, const bf16_t* kbuf, const bf16_t* vbuf, const bf16_t* gbuf, bf16_t* obuf, const float* B, const float* gq, const float* gk, char* ldsg, const int wave) {
    constexpr int NITEMS = 65 * HF + DB * HF; const int lane = lane_id_opaque(); const bool t0 = wave == 0 && lane == 0;
    volatile LAS unsigned* qw = (volatile LAS unsigned*)(LAS char*)(ldsg + fa::OFF_Q);

    float gm = fmaxf(fabsf(gq[lane]), fabsf(gq[lane + 64])), km = fmaxf(fabsf(gk[lane]), fabsf(gk[lane + 64]));
#pragma unroll
    for (int o = 1; o < 64; o <<= 1) { gm = fmaxf(gm, __shfl_xor(gm, o)); km = fmaxf(km, __shfl_xor(km, o)); }
    const float qb = 1.4426950408889634f * 11.313708498984761f * 1.02f * gm * km, thr = FA_CUT + 2.0f * qb;
    const fa::Bases BS{qbuf, kbuf, vbuf, gbuf, B, obuf, FA_CUT + qb};
#define FA_FETCH(dst) do { if (t0) qw[0] = __hip_atomic_fetch_add(head_word, 1u, RLX_AGENT); __syncthreads(); dst = __builtin_amdgcn_readfirstlane((int)qw[0]); } while (0)
    int ci; FA_FETCH(ci);
    if (ci < NITEMS) {
        fa::BlockRef cur = fa_ref(ci, B, thr, lane); fa::Seam S;
        fa::attn_prime(BS, cur, ldsg, S, wave);
        for (;;) { int ni; FA_FETCH(ni); const bool last = ni >= NITEMS; const fa::BlockRef nxt = last ? cur : fa_ref(ni, B, thr, lane);
            fa::attn_block(BS, cur, nxt, ldsg, S, wave); if (last) break; cur = nxt; }
    }
#undef FA_FETCH
}
__device__ __forceinline__ void ret_state_phase(const float* S0, bf16_t* BTS, LAS unsigned char* lds, int gw, int ngw, int wave) {
    const int lane = lane_id_opaque();
    LAS float* scr = (LAS float*)(lds + wave * 16384);
    for (int it = gw; it < DB * HR * 64; it += ngw) { const int mtx = it >> 6, b = mtx >> 3, head = mtx & 7, tile = b >> 2, bb = b & 3;
        transpose_item(S0 + (size_t)mtx * DKR * DVR, DVR, 16, BTS + (((size_t)head * 4 + tile) * 512) * 1280 + 256 + 256 * bb, 1280, scr, it & 63, lane); }
}
__device__ __forceinline__ void ret_transpose_phase(const bf16_t* krn, bf16_t* kTp, bf16_t* kTs, LAS unsigned char* lds, int gw, int ngw, int wave) {
    const int lane = lane_id_opaque();
    LAS unsigned char* scr = lds + wave * 16384;
    const int bx = (int)blockIdx.x; const bool bal = (ngw == 2048);
    const int s0 = !bal ? gw : (bx < 40 ? bx * 8 + wave : 320 + ((bx - 40) * 8 + wave) * 2), ns = (bal && bx >= 40) ? 2 : 1, st = bal ? 3776 : ngw;
    for (int kk = 0;; ++kk) { const int it = ns == 2 ? s0 + (kk & 1) + (kk >> 1) * st : s0 + kk * st; if (it >= NTILE * 4 * 32) break;
        const int pm = it >> 7, rg = (it >> 5) & 3, cg = it & 31, row0 = pm * 256 + rg * 64, col0 = cg * 64;
        u32x4 tt[8];
#pragma unroll
        for (int i = 0; i < 8; ++i) tt[i] = *(const u32x4*)(krn + (size_t)(row0 + 8 * i + (lane >> 3)) * DM + col0 + 8 * (lane & 7));
#pragma unroll
        for (int i = 0; i < 8; ++i) { LAS unsigned* d = (LAS unsigned*)(scr + (8 * i + (lane >> 3)) * 132 + 16 * (lane & 7)); d[0] = tt[i][0]; d[1] = tt[i][1]; d[2] = tt[i][2]; d[3] = tt[i][3]; }
        LDS_WAIT(); asm volatile("" ::: "memory");
#pragma unroll 8
        for (int i = 0; i < 32; ++i) { const int d = 2 * i + (lane >> 5), t2 = (lane & 31) * 2;
            const unsigned lo = *(const LAS unsigned short*)(scr + t2 * 132 + d * 2), hi = *(const LAS unsigned short*)(scr + (t2 + 1) * 132 + d * 2); const unsigned w = lo | (hi << 16);
            if (pm >= 4) *(unsigned*)(kTp + (size_t)(col0 + d) * MROWS + row0 + t2) = w;
            else { const int head = cg >> 2, dk = (cg & 3) * 64 + d;
#pragma unroll
                for (int bb = 0; bb < 4; ++bb) *(unsigned*)(kTs + ((((size_t)head * 4 + pm) * 4 + bb) * 256 + dk) * 256 + rg * 64 + t2) = bb == rg ? w : 0u; } }
        LDS_WAIT(); asm volatile("" ::: "memory");
    }
}
__device__ __forceinline__ void ret_prefix_phase(bf16_t* BT, float* out_state, int gw, int ngw) {
    const int gt = gw * 64 + lane_id_opaque(), ngt = ngw * 64;
    for (int e = gt; e < HR * 512 * 32; e += ngt) { const int head = e >> 14, dv = (e >> 5) & 511, dk8 = (e & 31) * 8;
        const float g256 = __builtin_amdgcn_exp2f(ret_lg2gamma(head) * 256.0f); float s[8];
#pragma unroll
        for (int k = 0; k < 8; ++k) s[k] = 0.f;
        bf16_t* p = BT + (((size_t)head * 65) * 512 + dv) * 512 + 256 + dk8;
        for (int b0 = 0; b0 < 65; b0 += 13) { u32x4 uu[13];
#pragma unroll
            for (int b = 0; b < 13; ++b) uu[b] = *(const u32x4*)(p + (size_t)(b0 + b) * 512 * 512);
#pragma unroll
            for (int b = 0; b < 13; ++b) { const u32x4 u = uu[b];
                u32x4 w; w.x = cvt_pk_bf16(s[0], s[1]); w.y = cvt_pk_bf16(s[2], s[3]); w.z = cvt_pk_bf16(s[4], s[5]); w.w = cvt_pk_bf16(s[6], s[7]); *(u32x4*)(p + (size_t)(b0 + b) * 512 * 512) = w;
#pragma unroll
                for (int k = 0; k < 4; ++k) { s[2 * k] = s[2 * k] * g256 + __uint_as_float(u[k] << 16); s[2 * k + 1] = s[2 * k + 1] * g256 + __uint_as_float(u[k] & 0xffff0000u); } } }
#pragma unroll
        for (int k = 0; k < 8; ++k) out_state[((size_t)head * DKR + dk8 + k) * DVR + dv] = s[k]; }
}
constexpr int N_PHASES = 37;
struct Args { const float* in[20]; float* out; unsigned char* ws; int ph_lo, ph_hi; };
__global__ void __launch_bounds__(512, 2) fwd_kernel(Args args) {
    extern __shared__ __attribute__((aligned(16))) unsigned char shm[];
    LAS unsigned char* lds = (LAS unsigned char*)shm;
    const int wave = __builtin_amdgcn_readfirstlane((int)threadIdx.x >> 6);
    unsigned char* const ws0 = args.ws; const float* const* const in0 = args.in; float* const out0 = args.out;
    unsigned* ctl = (unsigned*)(ws0 + WS_CTL);
#define LAUNDER() int lz_; asm volatile("s_mov_b32 %0, 0" : "=s"(lz_)); unsigned char* const ws = ws0 + lz_; const float* const* const in = in0 + lz_; float* const out = out0 + lz_; \
    const int G = (int)gridDim.x + lz_, bx = (int)blockIdx.x, vcu = (G % 8 == 0) ? (bx % 8) * (G / 8) + bx / 8 : bx, gw = vcu * 8 + wave, ngw = G * 8; (void)gw; (void)ngw; (void)in; (void)out
    for (int u = (int)threadIdx.x; u < (LDS_BYTES - MISC_OFF) / 4; u += 512) ((LAS unsigned*)(lds + MISC_OFF))[u] = 0u;
    __syncthreads();
    const bool fold_scan = ((int)gridDim.x == 256);
    const int lo = args.ph_lo, hi = args.ph_hi - ((fold_scan && args.ph_hi == N_PHASES) ? 2 : 0);
    XcdBarrier bar; bar.bar = ctl + CW_BAR; bar.x = 0; bar.st = (volatile LAS unsigned*)(lds + MISC_OFF);
    if (hi - lo > 1) bar = xcd_barrier_post(ctl + CW_BAR, (volatile LAS unsigned*)(lds + MISC_OFF), threadIdx.x == 0);
    int ph = 0;
#define PH_ON (lo <= ph && ph < hi)
#define HP ((float*)(ws + WS_H))
#define XNP ((bf16_t*)(ws + WS_XN))
#define SLABP ((float*)(ws + WS_SLAB))
#define PH_END do { if (lo <= ph && ph + 1 < hi) xcd_barrier(bar, wave == 0 && lane_id_opaque() == 0); ++ph; } while (0)

    if (PH_ON) { LAUNDER(); prologue_phase(in, ws, lds, gw, ngw, wave);
        fox_cache_phase(in[2], in[3], (bf16_t*)(ws + R_K), (bf16_t*)(ws + R_V), gw, ngw, G != 256);
    }
    PH_END;
    for (int i = 0; i < 4; ++i) {
        const int j = i >> 1;
        if ((i & 1) == 0) {
#define qbuf ((bf16_t*)(ws + R_Q))
#define kbuf ((bf16_t*)(ws + R_K))
#define vbuf ((bf16_t*)(ws + R_V))
#define gbuf ((bf16_t*)(ws + R_G))
#define lf ((float*)(ws + WS_LF))
#define bP ((float*)(ws + WS_BP))
#define bS ((float*)(ws + WS_BS))
            if (i > 0) {
            if (PH_ON) { LAUNDER(); norm_rows_bf16(HP, in[7] + (size_t)i * DM, XNP, SLABP, gw, ngw);
                fox_cache_phase(in[2] + (size_t)j * DB * PAST * DM, in[3] + (size_t)j * DB * PAST * DM, kbuf, vbuf, gw, ngw, G != 256); }
            PH_END;
            }
            if (PH_ON) { LAUNDER(); pg8::SchedFoxIn S{(const char*)XNP, (const char*)(ws + WS_WFI + j * SZ_WFI), G, bx};
                pg8::EpiFoxIn E{qbuf, kbuf, vbuf, gbuf, lf, in[11] + j * DHF, in[12] + j * DHF, in[13] + j * HF,
                                out + O_FKP + (size_t)j * LP * DM, out + O_FVP + (size_t)j * LP * DM, out + O_FLP + (size_t)j * LP * HF,
                                out + O_FKS + (size_t)j * DB * DS * DM, out + O_FVS + (size_t)j * DB * DS * DM, out + O_FLS + (size_t)j * DB * DS * HF, (LAS float*)(lds + XL_OFF), G == 256 ? in[2] + (size_t)j * DB * PAST * DM : nullptr, in[3] + (size_t)j * DB * PAST * DM,
                                fold_scan ? (unsigned*)(ws + WS_CTL) + CW_SCAN + 64 * j : nullptr, in[4] + (size_t)j * DB * PAST * HF, bP, bS};
                pg8::gemm_phase(lds, pg8::Shape{DM, DM}, S, E, wave);
                }
            PH_END;
            if (!fold_scan) {
            if (PH_ON) { LAUNDER(); scan_phase(lf, in[4] + (size_t)j * DB * PAST * HF, bP, bS, lds, wave); }
            PH_END;
            }
            if (PH_ON) { LAUNDER(); attn_phase((unsigned*)(ws + WS_CTL) + CW_ATTN + 64 * j, qbuf, kbuf, vbuf, gbuf, XNP, bP, in[11] + j * DHF, in[12] + j * DHF, (char*)shm, wave);
                }
            PH_END;
            if (PH_ON) { LAUNDER(); pg8::SchedResid S{(const char*)XNP, (const char*)(ws + WS_WFO + j * SZ_WFO), G, bx, (size_t)256 * DM * 2, (size_t)256 * DM * 2, DM / 64};
                pg8::EpiResid E{HP, SLABP}; pg8::gemm_phase(lds, pg8::Shape{DM, DM}, S, E, wave); }
            PH_END;
        } else {
#define sg ((bf16_t*)(ws + R_SG))
#define AP ((bf16_t*)(ws + R_AP))
#define BT ((bf16_t*)(ws + R_BT))
#define krn ((bf16_t*)(ws + R_KRN))
#define kTp ((bf16_t*)(ws + R_KTP))
#define ob ((bf16_t*)(ws + R_OB))
#define APS ((bf16_t*)(ws + R_APS))
#define BTS ((bf16_t*)(ws + R_BTS))
#define kTs ((bf16_t*)(ws + R_KTS))
            if (PH_ON) { LAUNDER(); norm_rows_bf16(HP, in[7] + (size_t)i * DM, XNP, i > 0 ? SLABP : nullptr, gw, ngw);
                if (G != 256) ret_state_phase(in[5] + (size_t)j * DB * HR * DKR * DVR, BTS, lds, gw, ngw, wave); }
            PH_END;
            if (PH_ON) { LAUNDER(); pg8::SchedRetIn S{(const char*)XNP, (const char*)(ws + WS_WRI + j * SZ_WRI), G, bx};
                pg8::EpiRetIn E{AP, APS, krn, sg, BT, BTS, (const float*)(ws + WS_COS), (const float*)(ws + WS_SIN)};
                pg8::gemm_phase(lds, pg8::Shape{DM, DM}, S, E, wave);
                }
            PH_END;
            if (PH_ON) { LAUNDER(); ret_transpose_phase(krn, kTp, kTs, lds, gw, ngw, wave); __syncthreads();
                pg8::SchedG1 S{(const char*)AP, (const char*)krn, G, bx}; pg8::EpiG1 E{AP, APS};
                pg8::gemm_phase(lds, pg8::Shape{512, DM}, S, E, wave);
                }
            PH_END;
            if (PH_ON) { LAUNDER(); { pg8::SchedG2p S{(const char*)BT, (const char*)kTp, G, bx}; pg8::EpiG2p E{BT}; pg8::gemm_phase(lds, pg8::Shape{512, MROWS}, S, E, wave); }
                }
            PH_END;
            if (PH_ON) { LAUNDER(); ret_prefix_phase(BT, out + O_RSP + (size_t)j * HR * DKR * DVR, gw, ngw); }
            PH_END;
            if (PH_ON) { LAUNDER(); { pg8::SchedG3p S{(const char*)AP, (const char*)BT, G, bx}; pg8::EpiG3 E{ob, sg, in[16] + (size_t)j * HR * DVR, (LAS float*)(lds + XL_OFF), (LAS float*)(lds + XL_OFF + 4096)}; pg8::gemm_phase(lds, pg8::Shape{512, 512}, S, E, wave); }
                { pg8::SchedG3s S{(const char*)APS, (const char*)BTS, G, bx}; pg8::EpiG3 E{ob, sg, in[16] + (size_t)j * HR * DVR, (LAS float*)(lds + XL_OFF), (LAS float*)(lds + XL_OFF + 4096)}; pg8::gemm_phase(lds, pg8::Shape{1280, 1280}, S, E, wave); }
                { const bool pool = (G == 256); const int Gs = pool ? 184 : G, cs = pool ? bx - 40 : bx;
                  if (cs >= 0 && cs < Gs) { pg8::SchedG2s S{(const char*)kTs, (const char*)BTS, Gs, cs}; pg8::EpiG2s E{in[5] + (size_t)j * DB * HR * DKR * DVR, out + O_RSS + (size_t)j * DB * HR * DKR * DVR};
                      pg8::gemm_phase(lds, pg8::Shape{256, 1280}, S, E, wave); } }
                }
            PH_END;
            if (PH_ON) { LAUNDER(); pg8::SchedResid S{(const char*)ob, (const char*)(ws + WS_WRO + j * SZ_WRO), G, bx, (size_t)256 * DVT * 2, (size_t)256 * DVT * 2, DVT / 64};
                pg8::EpiResid E{HP, SLABP}; pg8::gemm_phase(lds, pg8::Shape{DVT, DVT}, S, E, wave); }
            PH_END;
        }
#define ub ((bf16_t*)(ws + R_U))
        if (PH_ON) { LAUNDER(); norm_rows_bf16(HP, in[8] + (size_t)i * DM, XNP, SLABP, gw, ngw);
            }
        PH_END;
        if (PH_ON) { LAUNDER(); pg8::SchedSimple S{(const char*)XNP, (const char*)(ws + WS_WUP + i * SZ_WUP), NTILE, 32, G, bx, (size_t)256 * DM * 2, (size_t)256 * DM * 2, DM / 64};
            pg8::EpiUp E{ub}; pg8::gemm_phase(lds, pg8::Shape{DM, DM}, S, E, wave);
            if ((i & 1) == 0 && G == 256 && bx >= 160) ret_state_phase(in[5] + (size_t)(i >> 1) * DB * HR * DKR * DVR, (bf16_t*)(ws + R_BTS), lds, (bx - 160) * 8 + wave, 96 * 8, wave);
            }
        PH_END;
        if (PH_ON) { LAUNDER(); pg8::SchedResid S{(const char*)ub, (const char*)(ws + WS_WDN + i * SZ_WDN), G, bx, (size_t)256 * DFFP * 2, (size_t)256 * DFFP * 2, DFF / 64};
            pg8::EpiResid E{HP, SLABP}; pg8::gemm_phase(lds, pg8::Shape{DFFP, DFFP}, S, E, wave);
            }
        PH_END;
    }
    if (PH_ON) { LAUNDER(); norm_rows_out(HP, in[9], out, SLABP, gw, ngw); }
#undef PH_ON
#undef qbuf
#undef kbuf
#undef vbuf
#undef gbuf
#undef lf
#undef bP
#undef bS
#undef sg
#undef AP
#undef BT
#undef krn
#undef kTp
#undef ob
#undef APS
#undef BTS
#undef kTs
#undef ub
#undef HP
#undef XNP
#undef SLABP
#undef LAUNDER
#undef PH_END
}

#ifndef MK_PER_PHASE
#define MK_PER_PHASE 0
#endif
extern "C" void kernel_launch(void* const* d_in, const int* in_sizes, int n_in, void* d_out, int out_size, void* d_ws, size_t ws_size, hipStream_t stream) {
    static int grid = 0;
    if (grid == 0) {
        if (n_in != 20 || (size_t)out_size != O_END || ws_size < WS_END) { fprintf(stderr, "kernel_launch: unexpected shapes (n_in %d, out %d, ws %zu; need ws >= %zu)\n", n_in, out_size, ws_size, (size_t)WS_END); grid = -1; return; }
        int dev = 0, cus = 0, per_cu = 0;
        if (hipGetDevice(&dev) != hipSuccess || hipDeviceGetAttribute(&cus, hipDeviceAttributeMultiprocessorCount, dev) != hipSuccess) { grid = -1; return; }
        if (hipFuncSetAttribute((const void*)fwd_kernel, hipFuncAttributeMaxDynamicSharedMemorySize, LDS_BYTES) != hipSuccess) { fprintf(stderr, "kernel_launch: hipFuncSetAttribute failed\n"); grid = -1; return; }
        if (hipOccupancyMaxActiveBlocksPerMultiprocessor(&per_cu, (const void*)fwd_kernel, 512, LDS_BYTES) != hipSuccess || per_cu < 1) fprintf(stderr, "kernel_launch: occupancy query reports %d\n", per_cu);
        (void)hipGetLastError();
        grid = cus;
    }
    if (grid < 0) return;
    if (hipMemsetAsync((char*)d_ws + WS_CTL, 0, CTL_ZERO_BYTES, stream) != hipSuccess) return;
    Args a{};
    for (int i = 0; i < 20; ++i) a.in[i] = (const float*)d_in[i];
    a.out = (float*)d_out; a.ws = (unsigned char*)d_ws;
#if MK_PER_PHASE
    for (int p = 0; p < N_PHASES; ++p) { a.ph_lo = p; a.ph_hi = p + 1; hipLaunchKernelGGL(fwd_kernel, dim3(grid), dim3(512), LDS_BYTES, stream, a); }
#else
    a.ph_lo = 0; a.ph_hi = N_PHASES;
    hipLaunchKernelGGL(fwd_kernel, dim3(grid), dim3(512), LDS_BYTES, stream, a);
#endif
}
```

```cpp
#include <hip/hip_runtime.h>
#include <cstdio>
#include <cstdint>

#define LAS __attribute__((address_space(3)))
#define GAS __attribute__((address_space(1)))
typedef unsigned short bf16_t;
typedef short bf16x8 __attribute__((ext_vector_type(8)));
typedef short s16x4 __attribute__((ext_vector_type(4)));
typedef float f32x2 __attribute__((ext_vector_type(2)));
typedef float f32x4 __attribute__((ext_vector_type(4)));
typedef float f32x16 __attribute__((ext_vector_type(16)));
typedef unsigned u32x2 __attribute__((ext_vector_type(2)));
typedef unsigned u32x4 __attribute__((ext_vector_type(4)));
typedef GAS unsigned gu32;

constexpr int DM = 2048, SEQ = 16384, NMETA = 16, LP = NMETA + SEQ, DB = 16, DS = 64, PAST = 1024, SKS = PAST + DS;
constexpr int HF = 16, DHF = 128, HR = 8, DKR = 256, DVR = 512, DVT = 4096, DFF = 8192;
constexpr int NFOXIN = 4 * DM + HF, NRETIN = 12288;
constexpr int DFFP = DFF;
constexpr int ROW_PAD = 1024, ROW_P0 = 1264, MROWS = 17664, NTILE = 69;
constexpr int KB_ROWS = 34096;
constexpr int KB_PROMPT0 = 16384 + ROW_P0;
constexpr int BP_LEN = 16448;
constexpr float EPS = 1e-6f;
constexpr int SLAB_ROW0 = 16384, SLAB_ROWS = MROWS - SLAB_ROW0, NSLAB = 6;
constexpr size_t O_YP = 0, O_YS = O_YP + (size_t)SEQ * DM, O_FKP = O_YS + (size_t)DB * DS * DM, O_FVP = O_FKP + (size_t)2 * LP * DM, O_FLP = O_FVP + (size_t)2 * LP * DM,
                 O_RSP = O_FLP + (size_t)2 * LP * HF, O_FKS = O_RSP + (size_t)2 * HR * DKR * DVR, O_FVS = O_FKS + (size_t)2 * DB * DS * DM, O_FLS = O_FVS + (size_t)2 * DB * DS * DM,
                 O_RSS = O_FLS + (size_t)2 * DB * DS * HF, O_END = O_RSS + (size_t)2 * DB * HR * DKR * DVR;

__device__ __forceinline__ unsigned cvt_pk_bf16(float lo, float hi) { unsigned r; asm volatile("v_cvt_pk_bf16_f32 %0, %1, %2" : "=v"(r) : "v"(lo), "v"(hi)); return r; }
__device__ __forceinline__ float bf2f(unsigned short b) { return __uint_as_float(((unsigned)b) << 16); }
__device__ __forceinline__ u32x4 pack8f(f32x4 a, f32x4 b) { u32x4 w; w.x = cvt_pk_bf16(a[0], a[1]); w.y = cvt_pk_bf16(a[2], a[3]); w.z = cvt_pk_bf16(b[0], b[1]); w.w = cvt_pk_bf16(b[2], b[3]); return w; }
#ifndef ST16_MODE
#define ST16_MODE 0
#endif
__device__ __forceinline__ void st16(void* p, u32x4 v) {
#if ST16_MODE == 1
    asm volatile("global_store_dwordx4 %0, %1, off sc1" :: "v"(p), "v"(v) : "memory");
#elif ST16_MODE == 2
    asm volatile("global_store_dwordx4 %0, %1, off nt" :: "v"(p), "v"(v) : "memory");
#else
    *(u32x4*)p = v;
#endif
}
__device__ __forceinline__ float wave_sum(float v) {
#pragma unroll
    for (int o = 1; o < 64; o <<= 1) v += __shfl_xor(v, o);
    return v;
}
__device__ __forceinline__ int kv_rowmap(int r) { return r < ROW_PAD ? (r >> 6) * SKS + PAST + (r & 63) : 16384 + r; }
__device__ __forceinline__ int lane_id() { return (int)__builtin_amdgcn_mbcnt_hi(~0u, __builtin_amdgcn_mbcnt_lo(~0u, 0u)); }
__device__ __forceinline__ int lane_id_opaque() { int l; asm volatile("v_mbcnt_lo_u32_b32 %0, -1, 0\n\tv_mbcnt_hi_u32_b32 %0, -1, %0" : "=v"(l)); return l; }
__device__ __forceinline__ int opaque_zero() { int z; asm volatile("v_mov_b32 %0, 0" : "=v"(z)); return z; }
__device__ __forceinline__ float ret_lg2gamma(int h) { return __builtin_log2f(1.0f - __builtin_exp2f(-5.0f - (float)h)); }

namespace pg8 {
constexpr int BM = 256, BK = 64, HALF = 128, HTB = HALF * BK * 2, STAGE_BYTES = 8 * HTB, NXCD = 8;
__host__ __device__ __forceinline__ int lds_byte(int r, int c) { const int st = (r >> 4) * 2 + (c >> 5), rr = r & 15, cc = c & 31, ob = rr * 64 + cc * 2; return st * 1024 + (ob ^ (((ob >> 9) & 1) << 5)); }
__host__ __device__ __forceinline__ void stage_rc(int b, int& R, int& C) { const int st = b / 1024, sb = b % 1024, swz = sb ^ (((sb >> 9) & 1) << 5); R = (st >> 1) * 16 + swz / 64; C = (st & 1) * 32 + (swz % 64) / 2; }
__host__ __device__ __forceinline__ int perm32(int rho) { const int n = rho >> 4, i = rho & 15; return 8 * (i >> 2) + 4 * n + (i & 3); }

struct Unit { const char* a; const char* b; int pm, pn, kind, nt; };
struct Shape { int lda, ldb; };
template <int WG_M = 8>
__device__ __forceinline__ void tile_decode(int L, int nM, int nN, int& pm, int& pn) { constexpr int WGM = WG_M;
    const int nwg = nM * nN; int wgid = L;
    { const int q = nwg / NXCD, r = nwg % NXCD, xcd = wgid % NXCD, off = wgid / NXCD; wgid = (xcd < r ? xcd * (q + 1) : r * (q + 1) + (xcd - r) * q) + off; }
    const int nig = WGM * nN, gid = wgid / nig, fm = gid * WGM, gsz = (nM - fm) < WGM ? (nM - fm) : WGM;
    pm = fm + ((wgid % nig) % gsz); pn = (wgid % nig) / gsz;
}

template <class Epi, class Sched>
__device__ __forceinline__ void gemm_phase(LAS unsigned char* lds, const Shape g, const Sched& S, const Epi& E, const int wid) {
    const int lane = lane_id_opaque(), tid = wid * 64 + lane, wr = wid >> 2, wc = wid & 3, fr = lane & 15, fq = lane >> 4;
    unsigned voffA[2], voffB[2];
#pragma unroll
    for (int i = 0; i < 2; ++i) { int R, C; stage_rc(tid * 16 + i * 8192, R, C); const int Rb = Epi::PERM ? ((R & ~31) + perm32(R & 31)) : R;
        voffA[i] = (unsigned)(R * g.lda + C) * 2u; voffB[i] = (unsigned)(Rb * g.ldb + C) * 2u; }
    const size_t kstep = (size_t)(BK * 2);
    const size_t hstepA = (size_t)HALF * g.lda * 2, hstepB = (size_t)HALF * g.ldb * 2;
    const unsigned ldsw = (unsigned)wid * 1024u;
    const int aoff = lds_byte(wr * 64 + fr, fq * 8), boff = lds_byte(wc * 32 + fr, fq * 8);
#define PG8_SA(b, h) (((b) * 2 + (h)) * HTB)
#define PG8_SB(b, h) ((4 + (b) * 2 + (h)) * HTB)
#define PG8_STAGE(bufoff, gbase, voff) do { _Pragma("unroll") for (int _i = 0; _i < 2; ++_i) \
        __builtin_amdgcn_global_load_lds((const unsigned*)((const char*)(gbase) + (voff)[_i]), (LAS unsigned*)(lds + (bufoff) + ldsw + _i * 8192), 16, 0, 0); } while (0)
#define PG8_LDA(dst, b, h) do { _Pragma("unroll") for (int m = 0; m < 4; ++m) _Pragma("unroll") for (int k = 0; k < 2; ++k) dst[m][k] = *(const LAS bf16x8*)(lds + PG8_SA(b, h) + aoff + m * 2048 + k * 1024); } while (0)
#define PG8_LDB(dst, b, h) do { _Pragma("unroll") for (int n = 0; n < 2; ++n) _Pragma("unroll") for (int k = 0; k < 2; ++k) dst[n][k] = *(const LAS bf16x8*)(lds + PG8_SB(b, h) + boff + n * 2048 + k * 1024); } while (0)
#define PG8_MMA(ai, bj, At, Bt) do { __builtin_amdgcn_s_setprio(1); _Pragma("unroll") for (int m = 0; m < 4; ++m) _Pragma("unroll") for (int n = 0; n < 2; ++n) _Pragma("unroll") for (int k = 0; k < 2; ++k) \
        acc[ai][bj][m][n] = __builtin_amdgcn_mfma_f32_16x16x32_bf16(Bt[n][k], At[m][k], acc[ai][bj][m][n], 0, 0, 0); __builtin_amdgcn_s_setprio(0); } while (0)
#define PG8_WAIT_V(n) asm volatile("s_waitcnt vmcnt(" #n ")" ::: "memory")
#define PG8_WAIT_L(n) asm volatile("s_waitcnt lgkmcnt(" #n ")" ::: "memory")
#define PG8_BAR __builtin_amdgcn_s_barrier()
#define PG8_SCHED __builtin_amdgcn_sched_barrier(0)
    Unit cur, nxt; int ui = 0;
    if (!S.next(0, cur)) return;
    f32x4 acc[2][2][4][2];
#pragma unroll
    for (int a = 0; a < 2; ++a)
#pragma unroll
        for (int b = 0; b < 2; ++b)
#pragma unroll
            for (int m = 0; m < 4; ++m)
#pragma unroll
                for (int n = 0; n < 2; ++n) acc[a][b][m][n] = (f32x4){0.f, 0.f, 0.f, 0.f};
    bf16x8 At[4][2], B0[2][2], B1[2][2];
    const char* cA = cur.a; const char* cB = cur.b;
    PG8_STAGE(PG8_SB(0, 0), cB, voffB); PG8_STAGE(PG8_SB(0, 1), cB + hstepB, voffB); PG8_STAGE(PG8_SA(0, 0), cA, voffA); PG8_STAGE(PG8_SA(0, 1), cA + hstepA, voffA);
    if (wr == 1) PG8_BAR;
    PG8_WAIT_V(2); PG8_BAR;
    PG8_STAGE(PG8_SB(1, 0), cB + kstep, voffB); PG8_STAGE(PG8_SA(1, 0), cA + kstep, voffA); PG8_STAGE(PG8_SB(1, 1), cB + hstepB + kstep, voffB);
    PG8_WAIT_V(6); PG8_BAR;
    for (;;) {
        const bool has_next = S.next(ui + 1, nxt); const int nt = cur.nt;
        const char* nA = has_next ? nxt.a : cA; const char* nB = has_next ? nxt.b : cB;
#pragma nounroll
        for (int t = 0; t < nt; t += 2) {
            const bool last = (t == nt - 2);
            const char* a1 = cA + (size_t)(t + 1) * kstep;
            const char* a2 = last ? nA : cA + (size_t)(t + 2) * kstep; const char* b2 = last ? nB : cB + (size_t)(t + 2) * kstep;
            const char* a3 = a2 + kstep; const char* b3 = b2 + kstep;
            PG8_LDB(B0, 0, 0); PG8_LDB(B1, 0, 1); PG8_SCHED; PG8_LDA(At, 0, 0); PG8_STAGE(PG8_SA(1, 1), a1 + hstepA, voffA);
            PG8_WAIT_V(8); PG8_WAIT_L(0); PG8_BAR; PG8_MMA(0, 0, At, B0); PG8_MMA(0, 1, At, B1); PG8_BAR; PG8_SCHED;
            PG8_LDA(At, 0, 1); PG8_STAGE(PG8_SB(0, 0), b2, voffB); PG8_STAGE(PG8_SB(0, 1), b2 + hstepB, voffB); PG8_STAGE(PG8_SA(0, 0), a2, voffA);
            PG8_WAIT_V(8); PG8_WAIT_L(0); PG8_BAR; PG8_MMA(1, 0, At, B0); PG8_MMA(1, 1, At, B1); PG8_BAR; PG8_SCHED;
            PG8_LDB(B0, 1, 0); PG8_LDB(B1, 1, 1); PG8_SCHED; PG8_LDA(At, 1, 0); PG8_STAGE(PG8_SA(0, 1), a2 + hstepA, voffA);
            PG8_WAIT_V(8); PG8_WAIT_L(0); PG8_BAR; PG8_MMA(0, 0, At, B0); PG8_MMA(0, 1, At, B1); PG8_BAR; PG8_SCHED;
            PG8_LDA(At, 1, 1); PG8_STAGE(PG8_SB(1, 0), b3, voffB); PG8_STAGE(PG8_SB(1, 1), b3 + hstepB, voffB); PG8_STAGE(PG8_SA(1, 0), a3, voffA);
            PG8_WAIT_V(8); PG8_WAIT_L(0); PG8_BAR; PG8_MMA(1, 0, At, B0); PG8_MMA(1, 1, At, B1); PG8_BAR; PG8_SCHED;
        }
        if (wr == 0) PG8_BAR;
        E(acc, cur, wr, wc, fr, fq);
        E.side(ui, wid, lane);
        if (!has_next) break;
#pragma unroll
        for (int a = 0; a < 2; ++a)
#pragma unroll
            for (int b = 0; b < 2; ++b)
#pragma unroll
                for (int m = 0; m < 4; ++m)
#pragma unroll
                    for (int n = 0; n < 2; ++n) acc[a][b][m][n] = (f32x4){0.f, 0.f, 0.f, 0.f};
        cur = nxt; cA = nA; cB = nB; ++ui;
        if (wr == 1) PG8_BAR;
    }
    PG8_WAIT_V(0);
    PG8_BAR;
#undef PG8_SA
#undef PG8_SB
#undef PG8_STAGE
#undef PG8_LDA
#undef PG8_LDB
#undef PG8_MMA
#undef PG8_WAIT_V
#undef PG8_WAIT_L
#undef PG8_BAR
#undef PG8_SCHED
}
}
__device__ __forceinline__ void scan_job(int job, const float* lf, const float* clf, float* bP, float* bS, LAS double* sums, int wave);
namespace pg8 {
struct SchedFoxIn {
    const char* A; const char* Bt; int G, c;
    __device__ __forceinline__ bool next(int i, Unit& u) const {
        const long L = (long)i * G + c; if (L >= (long)NTILE * 33) return false;
        if (L < NTILE) { u.pm = (int)L; u.pn = 32; } else tile_decode<4>((int)L - NTILE, NTILE, 32, u.pm, u.pn);
        u.a = A + (size_t)u.pm * ((size_t)256 * DM * 2); u.b = Bt + (size_t)u.pn * ((size_t)256 * DM * 2); u.kind = 0; u.nt = DM / 64; return true; }
};
struct SchedSimple {
    const char* A; const char* Bt; int nM, nN, G, c; size_t astep, bstep; int nt;
    __device__ __forceinline__ bool next(int i, Unit& u) const {
        const long L = (long)i * G + c; if (L >= (long)nM * nN) return false;
        tile_decode<4>((int)L, nM, nN, u.pm, u.pn); u.a = A + (size_t)u.pm * astep; u.b = Bt + (size_t)u.pn * bstep; u.kind = 0; u.nt = nt; return true; }
};
struct SchedResid {
    const char* A; const char* Bt; int G, c; size_t astep, bstep; int nt;
    __device__ __forceinline__ bool next(int i, Unit& u) const {
        const long L = (long)i * G + c;
        if (L < 512) { tile_decode<4>((int)L, 64, 8, u.pm, u.pn);
            u.a = A + (size_t)u.pm * astep; u.b = Bt + (size_t)u.pn * bstep; u.kind = 0; u.nt = nt; return true; }
        const int s = (int)(L - 512); if (s >= 256) return false;
        int part, pmo, pno;
        if (G == 256) { const int g = 4 * (c & 7) + (c >> 6); if (g >= 30) return false; part = g / 5; pmo = g - 5 * part; pno = (c >> 3) & 7; }
        else { if (s >= 240) return false; const int q = s / 6; part = s - 6 * q; pmo = q >> 3; pno = q & 7; }
        const int e = nt >> 1, base = e / 6, r = e - 6 * base, k0 = part * base + (part < r ? part : r), np = base + (part < r ? 1 : 0);
        u.pm = 64 + pmo; u.pn = pno; u.kind = 1 + part; u.nt = 2 * np;
        u.a = A + (size_t)u.pm * astep + (size_t)k0 * 256; u.b = Bt + (size_t)u.pn * bstep + (size_t)k0 * 256; return true; }
};
struct SchedRetIn {
    const char* X; const char* W; int G, c;
    __device__ __forceinline__ bool next(int i, Unit& u) const {
        const long L = (long)i * G + c; constexpr int N0 = NTILE * 32, N1 = 16 * NTILE;
        if (L >= N0 + N1) return false;
        constexpr size_t ts = (size_t)256 * DM * 2;
        if (L < N0) { int pm, pn; tile_decode<4>((int)L, NTILE, 32, pm, pn); const int wt = pn < 16 ? pn : pn + 16;
            u.pm = pm; u.pn = wt; u.kind = 0; u.nt = DM / 64; u.a = X + (size_t)pm * ts; u.b = W + (size_t)wt * ts; }
        else { int pm, pn; tile_decode<4>((int)(L - N0), 16, NTILE, pm, pn); u.pm = pm; u.pn = pn; u.kind = 3; u.nt = DM / 64; u.a = W + (size_t)(16 + pm) * ts; u.b = X + (size_t)pn * ts; }
        return true; }
};
struct SchedG1 {
    const char* AP; const char* KRN; int G, c;
    __device__ __forceinline__ bool next(int i, Unit& u) const {
        const long L = (long)i * G + c; if (L >= NTILE * HR) return false;
        const int head = (int)L & 7, pm = (int)L >> 3; u.pm = pm; u.pn = 0; u.kind = head; u.nt = 4;
        u.a = AP + (((size_t)head * MROWS + (size_t)pm * 256) * 512 + 256) * 2; u.b = KRN + ((size_t)pm * 256 * DM + head * 256) * 2; return true; }
};
struct SchedG2p {
    const char* BT; const char* KTP; int G, c;
    __device__ __forceinline__ bool next(int i, Unit& u) const {
        const long L = (long)i * G + c; if (L >= HR * 65 * 2) return false;
        const int half = (int)L & 1, head = ((int)L >> 1) & 7, blk = (int)L >> 4; u.pm = blk; u.pn = half; u.kind = head; u.nt = 4;
        u.a = BT + ((((size_t)head * 65 + blk) * 512 + half * 256) * 512) * 2; u.b = KTP + ((size_t)head * 256 * MROWS + (size_t)(blk + 4) * 256) * 2; return true; }
};
struct SchedG2s {
    const char* KTS; const char* BTS; int G, c;
    __device__ __forceinline__ bool next(int i, Unit& u) const {
        const long L = (long)i * G + c; if (L >= DB * HR * 2) return false;
        const int half = (int)L & 1, head = ((int)L >> 1) & 7, b = (int)L >> 4, tile = b >> 2, bb = b & 3; u.pm = b; u.pn = half; u.kind = head; u.nt = 4;
        u.a = KTS + ((((size_t)head * 4 + tile) * 4 + bb) * 256 * 256) * 2; u.b = BTS + ((((size_t)head * 4 + tile) * 512 + half * 256) * 1280) * 2; return true; }
};
struct SchedG3p {
    const char* AP; const char* BT; int G, c;
    __device__ __forceinline__ bool next(int i, Unit& u) const {
        long p = (long)(i >> 1) * G + c;
        if (G == 256) { const int r = i >> 1;
            if (r == 0) p = c; else if (r == 1) { if (c >= 224) return false; p = 256 + c; } else if (r == 2) { if (c >= 40) return false; p = 480 + c; } else return false; }
        if (p >= HR * 65) return false;
        const int half = i & 1, head = (int)p & 7, blk = (int)p >> 3; u.pm = blk + 4; u.pn = half; u.kind = head; u.nt = 8;
        u.a = AP + (((size_t)head * MROWS + (size_t)(blk + 4) * 256) * 512) * 2; u.b = BT + ((((size_t)head * 65 + blk) * 512 + half * 256) * 512) * 2; return true; }
};
struct SchedG3s {
    const char* APS; const char* BTS; int G, c;
    __device__ __forceinline__ bool next(int i, Unit& u) const {
        const long p = (long)(i >> 1) * G + (G - 1 - c); if (p >= HR * 4) return false;
        const int half = i & 1, head = (int)p & 7, tile = (int)p >> 3; u.pm = tile; u.pn = half; u.kind = head; u.nt = 20;
        u.a = APS + (((size_t)head * 1024 + (size_t)tile * 256) * 1280) * 2; u.b = BTS + ((((size_t)head * 4 + tile) * 512 + half * 256) * 1280) * 2; return true; }
};

typedef const f32x4 (&AccRef)[2][2][4][2];

struct EpiResid { static constexpr bool PERM = false; float* H; float* SLAB;
    __device__ __forceinline__ void operator()(AccRef acc, const Unit& u, int wr, int wc, int fr, int fq) const {
        const int row0 = u.pm * BM + wr * 64 + fr + opaque_zero(), col0 = u.pn * BM + wc * 32 + 4 * fq + opaque_zero();
        if (u.kind == 0) {
#pragma unroll
            for (int ai = 0; ai < 2; ++ai)
#pragma unroll
                for (int mp = 0; mp < 2; ++mp) { u32x2 t[2][2][2];
#pragma unroll
                    for (int mm = 0; mm < 2; ++mm) { const bf16_t* rowp = (const bf16_t*)H + (size_t)(row0 + ai * HALF + (2 * mp + mm) * 16) * DM + col0;
#pragma unroll
                        for (int bj = 0; bj < 2; ++bj)
#pragma unroll
                            for (int n = 0; n < 2; ++n) t[mm][bj][n] = *(const u32x2*)(rowp + bj * HALF + n * 16); }
                    asm volatile("" ::: "memory");
#pragma unroll
                    for (int mm = 0; mm < 2; ++mm) { bf16_t* rowp = (bf16_t*)H + (size_t)(row0 + ai * HALF + (2 * mp + mm) * 16) * DM + col0;
#pragma unroll
                        for (int bj = 0; bj < 2; ++bj)
#pragma unroll
                            for (int n = 0; n < 2; ++n) { const u32x2 hw = t[mm][bj][n]; f32x4 hv; hv[0] = __uint_as_float(hw.x << 16); hv[1] = __uint_as_float(hw.x & 0xffff0000u); hv[2] = __uint_as_float(hw.y << 16); hv[3] = __uint_as_float(hw.y & 0xffff0000u); hv += acc[ai][bj][2 * mp + mm][n];
                                u32x2 ow; ow.x = cvt_pk_bf16(hv[0], hv[1]); ow.y = cvt_pk_bf16(hv[2], hv[3]); *(u32x2*)(rowp + bj * HALF + n * 16) = ow; } } }
        } else {
            bf16_t* sl = (bf16_t*)SLAB + (size_t)(u.kind - 1) * SLAB_ROWS * DM;
#pragma unroll
            for (int ai = 0; ai < 2; ++ai)
#pragma unroll
                for (int m = 0; m < 4; ++m) { bf16_t* rowp = sl + (size_t)(row0 - SLAB_ROW0 + ai * HALF + m * 16) * DM + col0;
#pragma unroll
                    for (int bj = 0; bj < 2; ++bj)
#pragma unroll
                        for (int n = 0; n < 2; ++n) { const f32x4 a = acc[ai][bj][m][n]; u32x2 w; w.x = cvt_pk_bf16(a[0], a[1]); w.y = cvt_pk_bf16(a[2], a[3]); *(u32x2*)(rowp + bj * HALF + n * 16) = w; } }
        }
    }
    __device__ __forceinline__ void side(int, int, int) const {}
};
struct EpiUp { static constexpr bool PERM = true; bf16_t* U;
    __device__ __forceinline__ void operator()(AccRef acc, const Unit& u, int wr, int wc, int fr, int fq) const {
        const int row0 = u.pm * BM + wr * 64 + fr + opaque_zero(), col0 = u.pn * BM + wc * 32 + 8 * fq + opaque_zero();
#pragma unroll
        for (int ai = 0; ai < 2; ++ai)
#pragma unroll
            for (int m = 0; m < 4; ++m) { bf16_t* rowp = U + (size_t)(row0 + ai * HALF + m * 16) * DFFP + col0;
#pragma unroll
                for (int bj = 0; bj < 2; ++bj) { f32x4 v0 = acc[ai][bj][m][0], v1 = acc[ai][bj][m][1];
#pragma unroll
                    for (int j = 0; j < 4; ++j) { const float a = fmaxf(v0[j], 0.f), b = fmaxf(v1[j], 0.f); v0[j] = a * a; v1[j] = b * b; }
                    st16(rowp + bj * HALF, pack8f(v0, v1)); } }
    }
    __device__ __forceinline__ void side(int, int, int) const {}
};
__device__ __forceinline__ float log_sigmoid_f(float x) { return x >= 0.f ? -log1pf(__expf(-x)) : x - log1pf(__expf(x)); }
__device__ __forceinline__ float sigmoid_f(float x) { return 1.0f / (1.0f + __expf(-x)); }
struct EpiFoxIn { static constexpr bool PERM = true;
    bf16_t *qbuf, *kbuf, *vbuf, *gbuf; float* lf; const float *gq, *gk, *bfb; float *okp, *ovp, *olp, *oks, *ovs, *ols; LAS float* xl; const float *CK, *CV;
    unsigned* cnt; const float* clf; float *bPp, *bSp;
    __device__ __forceinline__ void operator()(AccRef acc, const Unit& u, int wr, int wc, int fr, int fq) const {
        const int kind = u.pn >> 3, rt0 = wr * 64 + fr + opaque_zero(), dcol = wc * 32 + 8 * fq + opaque_zero();
        if (kind <= 1) {
#pragma unroll
            for (int ai = 0; ai < 2; ++ai)
#pragma unroll
                for (int m = 0; m < 4; ++m)
#pragma unroll
                    for (int bj = 0; bj < 2; ++bj) { const f32x4 a = acc[ai][bj][m][0], b = acc[ai][bj][m][1];
                        float s = (a[0] * a[0] + a[1] * a[1]) + (a[2] * a[2] + a[3] * a[3]) + (b[0] * b[0] + b[1] * b[1]) + (b[2] * b[2] + b[3] * b[3]);
                        s += __shfl_xor(s, 16); s += __shfl_xor(s, 32);
                        if (fq == 0) xl[((ai * HALF + rt0 + m * 16) * 2 + bj) * 4 + wc] = s; }
            asm volatile("s_waitcnt lgkmcnt(0)" ::: "memory"); __builtin_amdgcn_s_barrier(); asm volatile("" ::: "memory");
            const float* g = kind == 0 ? gq : gk; const f32x4 g0 = *(const f32x4*)(g + dcol), g1 = *(const f32x4*)(g + dcol + 4);
#pragma unroll
            for (int ai = 0; ai < 2; ++ai)
#pragma unroll
                for (int m = 0; m < 4; ++m) { const int rt = ai * HALF + rt0 + m * 16, row = u.pm * BM + rt;
#pragma unroll
                    for (int bj = 0; bj < 2; ++bj) { const f32x4 pp = *(const LAS f32x4*)(xl + (rt * 2 + bj) * 4);
                        const float rs = __builtin_amdgcn_rsqf(((pp[0] + pp[1]) + (pp[2] + pp[3])) * (1.0f / 128.0f) + EPS);
                        const f32x4 v0 = acc[ai][bj][m][0] * rs * g0, v1 = acc[ai][bj][m][1] * rs * g1; const int colh = (u.pn & 7) * BM + bj * HALF + dcol;
                        if (kind == 0) *(u32x4*)(qbuf + (size_t)row * DM + colh) = pack8f(v0, v1);
                        else { *(u32x4*)(kbuf + (size_t)kv_rowmap(row) * DM + colh) = pack8f(v0, v1);
                            float* o = row < ROW_PAD ? oks + (size_t)row * DM + colh : (row >= ROW_P0 ? okp + (size_t)(row - ROW_P0) * DM + colh : nullptr);
                            if (o) { *(f32x4*)o = v0; *(f32x4*)(o + 4) = v1; } } } }
        } else if (kind == 2) {
#pragma unroll
            for (int ai = 0; ai < 2; ++ai)
#pragma unroll
                for (int m = 0; m < 4; ++m) { const int rt = ai * HALF + rt0 + m * 16, row = u.pm * BM + rt;
#pragma unroll
                    for (int bj = 0; bj < 2; ++bj) { const f32x4 v0 = acc[ai][bj][m][0], v1 = acc[ai][bj][m][1]; const int colh = (u.pn & 7) * BM + bj * HALF + dcol;
                        *(u32x4*)(vbuf + (size_t)kv_rowmap(row) * DM + colh) = pack8f(v0, v1);
                        float* o = row < ROW_PAD ? ovs + (size_t)row * DM + colh : (row >= ROW_P0 ? ovp + (size_t)(row - ROW_P0) * DM + colh : nullptr);
                        if (o) { *(f32x4*)o = v0; *(f32x4*)(o + 4) = v1; } } }
        } else if (kind == 3) {
#pragma unroll
            for (int ai = 0; ai < 2; ++ai)
#pragma unroll
                for (int m = 0; m < 4; ++m) { const int rt = ai * HALF + rt0 + m * 16, row = u.pm * BM + rt;
#pragma unroll
                    for (int bj = 0; bj < 2; ++bj) { f32x4 v0 = acc[ai][bj][m][0], v1 = acc[ai][bj][m][1]; const int colh = (u.pn & 7) * BM + bj * HALF + dcol;
#pragma unroll
                        for (int j = 0; j < 4; ++j) { v0[j] = sigmoid_f(v0[j]); v1[j] = sigmoid_f(v1[j]); }
                        *(u32x4*)(gbuf + (size_t)row * DM + colh) = pack8f(v0, v1); } }
        } else {
            if (wc == 0 && dcol < 16) {
#pragma unroll
                for (int ai = 0; ai < 2; ++ai)
#pragma unroll
                    for (int m = 0; m < 4; ++m) { const int rt = ai * HALF + rt0 + m * 16, row = u.pm * BM + rt;
#pragma unroll
                        for (int n = 0; n < 2; ++n) { const int hd = dcol + 4 * n; const f32x4 bb = *(const f32x4*)(bfb + hd); f32x4 v = acc[ai][0][m][n] + bb;
#pragma unroll
                            for (int j = 0; j < 4; ++j) v[j] = log_sigmoid_f(v[j]);
                            if (cnt) { unsigned long long* lp = (unsigned long long*)(lf + (size_t)row * HF + hd);
                                __hip_atomic_store(lp, (unsigned long long)__float_as_uint(v[0]) | ((unsigned long long)__float_as_uint(v[1]) << 32), __ATOMIC_RELAXED, __HIP_MEMORY_SCOPE_AGENT);
                                __hip_atomic_store(lp + 1, (unsigned long long)__float_as_uint(v[2]) | ((unsigned long long)__float_as_uint(v[3]) << 32), __ATOMIC_RELAXED, __HIP_MEMORY_SCOPE_AGENT); }
                            else *(f32x4*)(lf + (size_t)row * HF + hd) = v;
                            float* o = row < ROW_PAD ? ols + (size_t)row * HF + hd : (row >= ROW_P0 ? olp + (size_t)(row - ROW_P0) * HF + hd : nullptr);
                            if (o) *(f32x4*)o = v; } }
            }
            if (cnt) { asm volatile("s_waitcnt vmcnt(0)" ::: "memory"); __builtin_amdgcn_s_barrier(); asm volatile("" ::: "memory");
                if (wr == 0 && wc == 0 && fr == 0 && fq == 0) (void)__hip_atomic_fetch_add(cnt, 1u, __ATOMIC_RELAXED, __HIP_MEMORY_SCOPE_AGENT); }
        }
    }
    __device__ __forceinline__ void side(int ui, int wid, int lane) const {
        if (CK && ui < 8) {
#pragma unroll
            for (int q = 0; q < 2; ++q) { const int t = ((int)blockIdx.x * 8 + ui) * 16 + 2 * wid + q, which = t >> 14, r = t & 16383;
                const f32x4* s = (const f32x4*)((which ? CV : CK) + (size_t)r * DM) + lane; u32x2* d = (u32x2*)((which ? vbuf : kbuf) + ((size_t)(r >> 10) * SKS + (r & 1023)) * DM) + lane;
                f32x4 y[8];
#pragma unroll
                for (int j = 0; j < 8; ++j) y[j] = s[64 * j];
#pragma unroll
                for (int j = 0; j < 8; ++j) { u32x2 w; w.x = cvt_pk_bf16(y[j][0], y[j][1]); w.y = cvt_pk_bf16(y[j][2], y[j][3]); d[64 * j] = w; } }
        }
        if (cnt && ui == 7 && (int)blockIdx.x >= 229) {
            if (wid == 0 && lane == 0) { unsigned sp = 0u; while (__hip_atomic_load(cnt, __ATOMIC_RELAXED, __HIP_MEMORY_SCOPE_AGENT) < (unsigned)NTILE) { __builtin_amdgcn_s_sleep(1); if (++sp > (1u << 22)) break; } }
            __syncthreads(); __builtin_amdgcn_fence(__ATOMIC_ACQUIRE, "agent"); asm volatile("s_waitcnt vmcnt(0)" ::: "memory");
            const int j0 = (int)blockIdx.x - 229;
            scan_job(j0, lf, clf, bPp, bSp, (LAS double*)xl, wid);
            if (j0 + 27 < 32) { __syncthreads(); scan_job(j0 + 27, lf, clf, bPp, bSp, (LAS double*)xl, wid); }
        }
    }
};
struct EpiRetIn { static constexpr bool PERM = true;
    bf16_t *AP, *APS, *krn, *sg, *BT, *BTS; const float *COS, *SIN;
    __device__ __forceinline__ void operator()(AccRef acc, const Unit& u, int wr, int wc, int fr, int fq) const {
        const int rt0 = wr * 64 + fr + opaque_zero(), dcol = wc * 32 + 8 * fq + opaque_zero();
        if (u.kind == 3) {
            const int head = u.pm >> 1;
#pragma unroll
            for (int ai = 0; ai < 2; ++ai)
#pragma unroll
                for (int m = 0; m < 4; ++m) { const int rt = ai * HALF + rt0 + m * 16, dvl = (u.pm & 1) * 256 + rt;
#pragma unroll
                    for (int bj = 0; bj < 2; ++bj) { const int tk = bj * HALF + dcol; u32x4 w = pack8f(acc[ai][bj][m][0], acc[ai][bj][m][1]);
                        if (u.pn >= 4) { if (u.pn == 4 && tk < 240) w = (u32x4){0u, 0u, 0u, 0u};
                            *(u32x4*)(BT + ((((size_t)head * 65 + (u.pn - 4)) * 512 + dvl) * 512 + tk)) = w; }
                        else *(u32x4*)(BTS + ((((size_t)head * 4 + u.pn) * 512 + dvl) * 1280 + tk)) = w; } }
        } else if (u.pn < 16) {
            const bool isq = u.pn < 8; const int head = u.pn & 7; const float lg = ret_lg2gamma(head);
#pragma unroll
            for (int ai = 0; ai < 2; ++ai)
#pragma unroll
                for (int m = 0; m < 4; ++m) { const int rt = ai * HALF + rt0 + m * 16, row = u.pm * BM + rt;
                    const int pos = row < ROW_PAD ? NMETA + PAST + (row & 63) : (row >= ROW_P0 ? row - ROW_P0 : 0);
                    const float e = (float)((row < ROW_PAD ? (row & 63) : (row & 255)) + 1);
                    float f = isq ? __builtin_amdgcn_exp2f(lg * e) : 0.0625f * __builtin_amdgcn_exp2f(-lg * e);
                    if (!isq && row >= ROW_PAD && row < ROW_P0) f = 0.f;
                    f32x4 o1[2], o2[2];
#pragma unroll
                    for (int n = 0; n < 2; ++n) { const f32x4 cs = *(const f32x4*)(COS + (size_t)pos * 128 + dcol + 4 * n), sn = *(const f32x4*)(SIN + (size_t)pos * 128 + dcol + 4 * n);
                        const f32x4 x1 = acc[ai][0][m][n], x2 = acc[ai][1][m][n]; o1[n] = (x1 * cs - x2 * sn) * f; o2[n] = (x1 * sn + x2 * cs) * f; }
                    const u32x4 w1 = pack8f(o1[0], o1[1]), w2 = pack8f(o2[0], o2[1]);
                    if (isq) { bf16_t* d = AP + (((size_t)head * MROWS + row) * 512 + 256 + dcol); *(u32x4*)d = w1; *(u32x4*)(d + 128) = w2;
                        if (row < ROW_PAD) { bf16_t* ds = APS + (((size_t)head * 1024 + row) * 1280 + 256 + dcol); const int slot = (row >> 6) & 3; const u32x4 z = (u32x4){0u, 0u, 0u, 0u};
#pragma unroll
                            for (int s = 0; s < 4; ++s) { *(u32x4*)(ds + s * 256) = s == slot ? w1 : z; *(u32x4*)(ds + s * 256 + 128) = s == slot ? w2 : z; } } }
                    else { bf16_t* d = krn + ((size_t)row * DM + head * 256 + dcol); *(u32x4*)d = w1; *(u32x4*)(d + 128) = w2; } }
        } else {
#pragma unroll
            for (int ai = 0; ai < 2; ++ai)
#pragma unroll
                for (int m = 0; m < 4; ++m) { const int rt = ai * HALF + rt0 + m * 16, row = u.pm * BM + rt;
#pragma unroll
                    for (int bj = 0; bj < 2; ++bj) { f32x4 v0 = acc[ai][bj][m][0], v1 = acc[ai][bj][m][1];
#pragma unroll
                        for (int j = 0; j < 4; ++j) { v0[j] = v0[j] * sigmoid_f(v0[j]); v1[j] = v1[j] * sigmoid_f(v1[j]); }
                        *(u32x4*)(sg + (size_t)row * DVT + (u.pn - 32) * BM + bj * HALF + dcol) = pack8f(v0, v1); } }
        }
    }
    __device__ __forceinline__ void side(int, int, int) const {}
};
struct EpiG1 { static constexpr bool PERM = true; bf16_t *AP, *APS;
    __device__ __forceinline__ void operator()(AccRef acc, const Unit& u, int wr, int wc, int fr, int fq) const {
        const int rt0 = wr * 64 + fr + opaque_zero(), dcol = wc * 32 + 8 * fq + opaque_zero(), head = u.kind;
#pragma unroll
        for (int ai = 0; ai < 2; ++ai)
#pragma unroll
            for (int m = 0; m < 4; ++m) { const int i = ai * HALF + rt0 + m * 16, row = u.pm * BM + i;
#pragma unroll
                for (int bj = 0; bj < 2; ++bj) { const int j0 = bj * HALF + dcol; f32x4 v0 = acc[ai][bj][m][0], v1 = acc[ai][bj][m][1];
#pragma unroll
                    for (int jj = 0; jj < 4; ++jj) { const int ja = j0 + jj, jb = j0 + 4 + jj;
                        const bool oka = ja <= i && (u.pm >= 4 || (ja >> 6) == (i >> 6)), okb = jb <= i && (u.pm >= 4 || (jb >> 6) == (i >> 6));
                        v0[jj] = oka ? v0[jj] : 0.f; v1[jj] = okb ? v1[jj] : 0.f; }
                    bf16_t* d = u.pm >= 4 ? AP + (((size_t)head * MROWS + row) * 512 + j0) : APS + (((size_t)head * 1024 + row) * 1280 + j0);
                    *(u32x4*)d = pack8f(v0, v1); } }
    }
    __device__ __forceinline__ void side(int, int, int) const {}
};
struct EpiG2p { static constexpr bool PERM = true; bf16_t* BT;
    __device__ __forceinline__ void operator()(AccRef acc, const Unit& u, int wr, int wc, int fr, int fq) const {
        const int rt0 = wr * 64 + fr + opaque_zero(), dcol = wc * 32 + 8 * fq + opaque_zero(), head = u.kind; const float g256 = __builtin_amdgcn_exp2f(ret_lg2gamma(head) * 256.0f);
#pragma unroll
        for (int ai = 0; ai < 2; ++ai)
#pragma unroll
            for (int m = 0; m < 4; ++m) { const int dvl = u.pn * 256 + ai * HALF + rt0 + m * 16;
#pragma unroll
                for (int bj = 0; bj < 2; ++bj)
                    *(u32x4*)(BT + ((((size_t)head * 65 + u.pm) * 512 + dvl) * 512 + 256 + bj * HALF + dcol)) = pack8f(acc[ai][bj][m][0] * g256, acc[ai][bj][m][1] * g256); }
    }
    __device__ __forceinline__ void side(int, int, int) const {}
};
struct EpiG2s { static constexpr bool PERM = false; const float* S0; float* OUT;
    __device__ __forceinline__ void operator()(AccRef acc, const Unit& u, int wr, int wc, int fr, int fq) const {
        const int rt0 = wr * 64 + fr + opaque_zero(), col0 = u.pn * 256 + wc * 32 + 4 * fq + opaque_zero(), head = u.kind; const float g64 = __builtin_amdgcn_exp2f(ret_lg2gamma(head) * 64.0f);
        const size_t base = ((size_t)u.pm * HR + head) * DKR * DVR;
#pragma unroll
        for (int ai = 0; ai < 2; ++ai)
#pragma unroll
            for (int m = 0; m < 4; ++m) { const int dk = ai * HALF + rt0 + m * 16; const size_t ro = base + (size_t)dk * DVR + col0; f32x4 t[2][2];
#pragma unroll
                for (int bj = 0; bj < 2; ++bj)
#pragma unroll
                    for (int n = 0; n < 2; ++n) t[bj][n] = *(const f32x4*)(S0 + ro + bj * HALF + n * 16);
#pragma unroll
                for (int bj = 0; bj < 2; ++bj)
#pragma unroll
                    for (int n = 0; n < 2; ++n) *(f32x4*)(OUT + ro + bj * HALF + n * 16) = (t[bj][n] + acc[ai][bj][m][n]) * g64; }
    }
    __device__ __forceinline__ void side(int, int, int) const {}
};
struct EpiG3 { static constexpr bool PERM = true; bf16_t* OB; const bf16_t* SG; const float* GN; LAS float* xl; LAS float* xs;
    __device__ __forceinline__ void operator()(AccRef acc, const Unit& u, int wr, int wc, int fr, int fq) const {
        const int rt0 = wr * 64 + fr + opaque_zero(), dcol = wc * 32 + 8 * fq + opaque_zero(), head = u.kind;
#pragma unroll
        for (int ai = 0; ai < 2; ++ai)
#pragma unroll
            for (int m = 0; m < 4; ++m) { float s = 0.f;
#pragma unroll
                for (int bj = 0; bj < 2; ++bj) { const f32x4 a = acc[ai][bj][m][0], b = acc[ai][bj][m][1];
                    s += (a[0] * a[0] + a[1] * a[1]) + (a[2] * a[2] + a[3] * a[3]) + (b[0] * b[0] + b[1] * b[1]) + (b[2] * b[2] + b[3] * b[3]); }
                s += __shfl_xor(s, 16); s += __shfl_xor(s, 32);
                if (fq == 0) xl[(ai * HALF + rt0 + m * 16) * 4 + wc] = s; }
        asm volatile("s_waitcnt lgkmcnt(0)" ::: "memory"); __builtin_amdgcn_s_barrier(); asm volatile("" ::: "memory");
        if (u.pn == 0) {
#pragma unroll
            for (int ai = 0; ai < 2; ++ai)
#pragma unroll
                for (int m = 0; m < 4; ++m) { const int rt = ai * HALF + rt0 + m * 16, row = u.pm * BM + rt;
                    if (wc == 0 && fq == 0) { const f32x4 pp = *(const LAS f32x4*)(xl + rt * 4); xs[rt] = (pp[0] + pp[1]) + (pp[2] + pp[3]); }
#pragma unroll
                    for (int bj = 0; bj < 2; ++bj) *(u32x4*)(OB + (size_t)row * DVT + head * 512 + bj * HALF + dcol) = pack8f(acc[ai][bj][m][0], acc[ai][bj][m][1]); }
        } else {
            f32x4 gn[2][2][2];
#pragma unroll
            for (int hf = 0; hf < 2; ++hf)
#pragma unroll
                for (int bj = 0; bj < 2; ++bj) { const int cl = hf * 256 + bj * HALF + dcol; gn[hf][bj][0] = *(const f32x4*)(GN + head * DVR + cl); gn[hf][bj][1] = *(const f32x4*)(GN + head * DVR + cl + 4); }
            u32x4 gvv[1][2][2], ovv[1][2];
#define G3_LOAD(buf, g_) do { const size_t ro_ = (size_t)(u.pm * BM + ((g_) >> 2) * HALF + rt0 + ((g_) & 3) * 16) * DVT + head * 512 + dcol; \
                _Pragma("unroll") for (int hf = 0; hf < 2; ++hf) _Pragma("unroll") for (int bj = 0; bj < 2; ++bj) gvv[buf][hf][bj] = *(const u32x4*)(SG + ro_ + hf * 256 + bj * HALF); \
                _Pragma("unroll") for (int bj = 0; bj < 2; ++bj) ovv[buf][bj] = *(const u32x4*)(OB + ro_ + bj * HALF); } while (0)
#pragma unroll
            for (int g = 0; g < 8; ++g) { const int ai = g >> 2, m = g & 3, cb = 0, rt = ai * HALF + rt0 + m * 16, row = u.pm * BM + rt;
                G3_LOAD(0, g); asm volatile("" ::: "memory");
                const f32x4 pp = *(const LAS f32x4*)(xl + rt * 4);
                const float rs = 1.0f / sqrtf((((pp[0] + pp[1]) + (pp[2] + pp[3])) + xs[rt]) * (1.0f / DVR) + EPS);
#pragma unroll
                for (int hf = 0; hf < 2; ++hf)
#pragma unroll
                    for (int bj = 0; bj < 2; ++bj) { const int cl = hf * 256 + bj * HALF + dcol; bf16_t* op = OB + (size_t)row * DVT + head * 512 + cl;
                        const u32x4 gv = gvv[cb][hf][bj]; const f32x4 n0 = gn[hf][bj][0], n1 = gn[hf][bj][1];
                        f32x4 v0, v1;
                        if (hf == 1) { v0 = acc[ai][bj][m][0]; v1 = acc[ai][bj][m][1]; }
                        else { const u32x4 ov = ovv[cb][bj]; v0[0] = __uint_as_float(ov[0] << 16); v0[1] = __uint_as_float(ov[0] & 0xffff0000u); v0[2] = __uint_as_float(ov[1] << 16); v0[3] = __uint_as_float(ov[1] & 0xffff0000u);
                            v1[0] = __uint_as_float(ov[2] << 16); v1[1] = __uint_as_float(ov[2] & 0xffff0000u); v1[2] = __uint_as_float(ov[3] << 16); v1[3] = __uint_as_float(ov[3] & 0xffff0000u); }
                        f32x4 g0, g1; g0[0] = __uint_as_float(gv[0] << 16); g0[1] = __uint_as_float(gv[0] & 0xffff0000u); g0[2] = __uint_as_float(gv[1] << 16); g0[3] = __uint_as_float(gv[1] & 0xffff0000u);
                        g1[0] = __uint_as_float(gv[2] << 16); g1[1] = __uint_as_float(gv[2] & 0xffff0000u); g1[2] = __uint_as_float(gv[3] << 16); g1[3] = __uint_as_float(gv[3] & 0xffff0000u);
                        *(u32x4*)op = pack8f(v0 * rs * n0 * g0, v1 * rs * n1 * g1); } }
#undef G3_LOAD
        }
    }
    __device__ __forceinline__ void side(int, int, int) const {}
};
}
namespace fa {
constexpr int NW = 8, QBLK = 32, KVBLK = 64, QB = NW * QBLK, D = 128, PITCH = DM;
constexpr int SHM_V = KVBLK * D * 2, SHM_K = KVBLK * D * 2;
constexpr int OFF_K = 2 * SHM_V, OFF_WS = OFF_K + 2 * SHM_K, OFF_B = OFF_WS + NW * 64 * 4, OFF_Q = OFF_B + 2 * 64 * 4, OFF_QL = 68608  , LDS_BYTES = OFF_QL + NW * 8192;
static_assert(OFF_Q + 64 <= OFF_QL, "lds map");
constexpr float C2 = 0.08838834764831845f * 1.4426950408889634f, THR2 = 8.0f * 1.4426950408889634f;

#define KSWZ(row, colB) ((row) * 256 + ((colB) ^ (((row) & 7) << 4)))
#define SBAR() __builtin_amdgcn_sched_barrier(0)
__device__ __forceinline__ int v_st(int k, int c) { const int kk = (k & ~0xC) | ((k & 4) << 1) | ((k & 8) >> 1); return ((kk >> 3) * 4 + (c >> 5)) * 512 + ((kk & 7) * 32 + (c & 31)) * 2; }
__device__ __forceinline__ int v_rd_base(int lane) { return ((lane & 3) << 3) | (((lane >> 2) & 3) << 6) | (((lane >> 4) & 1) << 5) | (((lane >> 5) & 1) << 8); }
constexpr int v_rd_off(int d0, int ks, int half) { return d0 * 512 + ks * 4096 + half * 2048; }
__device__ __forceinline__ int crow(int r, int hi) { return (r & 3) + 8 * (r >> 2) + 4 * hi; }
__device__ __forceinline__ bf16x8 load8(const bf16_t* p) { return *reinterpret_cast<const bf16x8*>(p); }
__device__ __forceinline__ void mask_tile(f32x16& p0, f32x16& p1, int dq) {
    const float NEG = -__builtin_inff();
#pragma unroll
    for (int r = 0; r < 16; ++r) { const int c = (r & 3) + 8 * (r >> 2); if (dq - c < 0) p0[r] = NEG; if (dq - c - 32 < 0) p1[r] = NEG; }
}
__device__ __forceinline__ void partialSM(f32x16& p0, f32x16& p1, float& m_reg, float& mn, float& alpha, const float* bl, int hi) {
#pragma unroll
    for (int g = 0; g < 4; ++g) { const f32x4 b0 = *(const f32x4*)(bl + 8 * g + 4 * hi), b1 = *(const f32x4*)(bl + 32 + 8 * g + 4 * hi);
#pragma unroll
        for (int j = 0; j < 4; ++j) { p0[4 * g + j] = fmaf(p0[4 * g + j], C2, b0[j]); p1[4 * g + j] = fmaf(p1[4 * g + j], C2, b1[j]); } }
    float pmax = p0[0];
#pragma unroll
    for (int r = 1; r < 16; ++r) pmax = fmaxf(pmax, p0[r]);
#pragma unroll
    for (int r = 0; r < 16; ++r) pmax = fmaxf(pmax, p1[r]);
    { auto rr = __builtin_amdgcn_permlane32_swap(__float_as_uint(pmax), __float_as_uint(pmax), false, false);
      pmax = fmaxf(__uint_as_float(rr[0]), __uint_as_float(rr[1])); }
    if (__builtin_expect(__all(pmax - m_reg <= THR2), 1)) { mn = m_reg; alpha = 1.f; }
    else { mn = fmaxf(m_reg, pmax); alpha = __builtin_amdgcn_exp2f(m_reg - mn); m_reg = mn; }
#pragma unroll
    for (int r = 0; r < 16; ++r) { p0[r] = p0[r] - mn; p1[r] = p1[r] - mn; }
#pragma unroll
    for (int r = 0; r < 16; ++r) p0[r] = __builtin_amdgcn_exp2f(p0[r]);
}
__device__ __forceinline__ void finishSM(f32x16& p0, f32x16& p1, float alpha, float& l_reg, bf16x8& pa0, bf16x8& pa1, bf16x8& pa2, bf16x8& pa3) {
#pragma unroll
    for (int r = 0; r < 16; ++r) p1[r] = __builtin_amdgcn_exp2f(p1[r]);
    float ps = 0;
#pragma unroll
    for (int r = 0; r < 16; ++r) ps += p0[r];
#pragma unroll
    for (int r = 0; r < 16; ++r) ps += p1[r];
    { auto rr = __builtin_amdgcn_permlane32_swap(__float_as_uint(ps), __float_as_uint(ps), false, false);
      ps = __uint_as_float(rr[0]) + __uint_as_float(rr[1]); }
    l_reg = l_reg * alpha + ps;
#define PK4(P, B_, OUT) do { unsigned a0 = cvt_pk_bf16(P[B_+0], P[B_+1]), a1 = cvt_pk_bf16(P[B_+2], P[B_+3]);                          \
        unsigned b0 = cvt_pk_bf16(P[B_+4], P[B_+5]), b1 = cvt_pk_bf16(P[B_+6], P[B_+7]);                                             \
        auto r0 = __builtin_amdgcn_permlane32_swap(a0, b0, false, false); auto r1 = __builtin_amdgcn_permlane32_swap(a1, b1, false, false); \
        u32x4 w = {r0[0], r1[0], r0[1], r1[1]}; OUT = *reinterpret_cast<bf16x8*>(&w); } while (0)
    PK4(p0, 0, pa0); PK4(p0, 8, pa1); PK4(p1, 0, pa2); PK4(p1, 8, pa3);
#undef PK4
}
template <int KB>
__device__ __forceinline__ void qkt(f32x16& p0, f32x16& p1, const char* K_lds, int r32, int hi, const char* ql, bool act) {
    if (!act) { const float NEG = -__builtin_inff();
#pragma unroll
        for (int r = 0; r < 16; ++r) { p0[r] = NEG; p1[r] = NEG; } return; }
    p0 = f32x16{}; p1 = f32x16{};
    const char* kb[4];
#pragma unroll
    for (int dd = 0; dd < 4; ++dd) kb[dd] = K_lds + KB * SHM_K + KSWZ(r32, (dd * 16 + hi * 8) * 2);
#pragma unroll
    for (int d0 = 0; d0 < 8; ++d0) { const char* a = kb[d0 & 3] + (d0 >> 2) * 128;
        bf16x8 b0 = *reinterpret_cast<const bf16x8*>(a);
        bf16x8 b1 = *reinterpret_cast<const bf16x8*>(a + 32 * 256);
        const bf16x8 qv = *reinterpret_cast<const bf16x8*>(ql + d0 * 1024);
        p0 = __builtin_amdgcn_mfma_f32_32x32x16_bf16(b0, qv, p0, 0, 0, 0);
        p1 = __builtin_amdgcn_mfma_f32_32x32x16_bf16(b1, qv, p1, 0, 0, 0); }
}
template <int VB>
__device__ __forceinline__ void pv_tile(f32x16* o, int vb0, bf16x8 pa0, bf16x8 pa1, bf16x8 pa2, bf16x8 pa3, bool act) {
    if (!act) return;
#define TRRD(dst, off) asm volatile("ds_read_b64_tr_b16 %0, %1 offset:%2" : "=&v"(dst) : "v"(vb0), "i"(off) : "memory")
#define PV_D0(d0) do { s16x4 l0, l1, l2, l3, h0, h1, h2, h3; constexpr int b_ = VB * SHM_V + v_rd_off(d0, 0, 0); \
        TRRD(l0, b_); TRRD(h0, b_ + 2048); TRRD(l1, b_ + 4096); TRRD(h1, b_ + 6144); TRRD(l2, b_ + 8192); TRRD(h2, b_ + 10240); TRRD(l3, b_ + 12288); TRRD(h3, b_ + 14336); \
        asm volatile("s_waitcnt lgkmcnt(0)" ::: "memory"); SBAR();   \
        o[d0] = __builtin_amdgcn_mfma_f32_32x32x16_bf16(pa0, (bf16x8){l0[0], l0[1], l0[2], l0[3], h0[0], h0[1], h0[2], h0[3]}, o[d0], 0, 0, 0);   \
        o[d0] = __builtin_amdgcn_mfma_f32_32x32x16_bf16(pa1, (bf16x8){l1[0], l1[1], l1[2], l1[3], h1[0], h1[1], h1[2], h1[3]}, o[d0], 0, 0, 0);   \
        o[d0] = __builtin_amdgcn_mfma_f32_32x32x16_bf16(pa2, (bf16x8){l2[0], l2[1], l2[2], l2[3], h2[0], h2[1], h2[2], h2[3]}, o[d0], 0, 0, 0);   \
        o[d0] = __builtin_amdgcn_mfma_f32_32x32x16_bf16(pa3, (bf16x8){l3[0], l3[1], l3[2], l3[3], h3[0], h3[1], h3[2], h3[3]}, o[d0], 0, 0, 0); } while (0)
    PV_D0(0); PV_D0(1); PV_D0(2); PV_D0(3);
#undef PV_D0
#undef TRRD
}
__device__ __forceinline__ int first_tile_above(const float* bb, float cut, int jmax, int lane) {
    const int stride = (jmax >> 6) + 1; int t1 = (lane + 1) * stride - 1; if (t1 > jmax) t1 = jmax;
    const unsigned long long m1 = __ballot(bb[t1 * 64] > cut); const int l1 = m1 ? (int)__builtin_ctzll(m1) : 63;
    const int base = l1 * stride; int t2 = base + (lane < stride ? lane : stride - 1); if (t2 > jmax) t2 = jmax;
    const unsigned long long m2 = __ballot(bb[t2 * 64] > cut); const int l2 = m2 ? (int)__builtin_ctzll(m2) : stride - 1;
    int jl = base + l2; if (jl > jmax) jl = jmax; return __builtin_amdgcn_readfirstlane(jl); }
struct Bases { const bf16_t* Q; const bf16_t* K; const bf16_t* V; const bf16_t* G; const float* B; bf16_t* O; float thr2; };
struct BlockRef { unsigned qo, ko, bo; float bref; int P0, jlo, jhi, nvw; };
struct Seam { bf16x8 st_v0, st_v1, st_k0, st_k1; float st_b; };
#define ROWP(p, k0, rr) ((const bf16_t*)((const char*)((p) + (size_t)(k0) * PITCH) + (unsigned)(((rr) * PITCH + sc) * 2)))
#define VMW() asm volatile("s_waitcnt vmcnt(0)" ::: "memory")
#define VMWN(n) asm volatile("s_waitcnt vmcnt(%0)" :: "i"(n) : "memory")
#define SLOAD_H(R_, k0) do { S.st_v0 = load8(ROWP(BS.V + (R_).ko, k0, sr)); S.st_v1 = load8(ROWP(BS.V + (R_).ko, k0, 32 + sr));              \
                         S.st_k0 = load8(ROWP(BS.K + (R_).ko, k0, sr)); S.st_k1 = load8(ROWP(BS.K + (R_).ko, k0, 32 + sr)); if (tid < 64) S.st_b = (BS.B + (R_).bo)[(k0) + tid] - (R_).bref; } while (0)
#define SWRITE_HK(bf) do { *(bf16x8*)(K_lds + (bf) * SHM_K + kws) = S.st_k0; *(bf16x8*)(K_lds + (bf) * SHM_K + kws + 32 * 256) = S.st_k1; if (tid < 64) B_lds[(bf) * 64 + tid] = S.st_b; } while (0)
#define SWRITE_HV(bf) do { *(bf16x8*)(V_lds + (bf) * SHM_V + vst0) = S.st_v0; *(bf16x8*)(V_lds + (bf) * SHM_V + vst1) = S.st_v1; } while (0)
#define SWRITE_H(bf) do { SWRITE_HV(bf); SWRITE_HK(bf); } while (0)
__device__ __forceinline__ void attn_prime(const Bases& BS, const BlockRef& cur, char* lds, Seam& S, const int wid) {
    const int lane = lane_id_opaque(), tid = wid * 64 + lane, r32 = lane & 31, hi = lane >> 5;
    const int sr = tid >> 4, sc = (tid & 15) * 8, kws = KSWZ(sr, sc * 2); char* K_lds = lds + OFF_K; float* B_lds = (float*)(lds + OFF_B);
    { char* ql = lds + OFF_QL + wid * 8192 + lane * 16; const bf16_t* qn = BS.Q + cur.qo + (size_t)(wid * QBLK + r32) * PITCH + hi * 8; bf16x8 tq[8];
#pragma unroll
      for (int d0 = 0; d0 < 8; ++d0) tq[d0] = load8(qn + d0 * 16);
#pragma unroll
      for (int d0 = 0; d0 < 8; ++d0) *reinterpret_cast<bf16x8*>(ql + d0 * 1024) = tq[d0]; }
    SLOAD_H(cur, (cur.jhi - 1) * KVBLK); VMW(); SWRITE_HK(0);
    __syncthreads();
}
__device__ __forceinline__ void attn_block(const Bases& BS, const BlockRef& cur, const BlockRef& nxt, char* lds, Seam& S, const int wid) {
    const int lane = lane_id_opaque(), tid = wid * 64 + lane, r32 = lane & 31, hi = lane >> 5;
    const int j_hi = cur.jhi; int NT = cur.jhi - cur.jlo, jlw = 0;
    const int qlo = cur.P0 + wid * QBLK, qm = qlo + r32 - 4 * hi;
    char* V_lds = lds; char* K_lds = lds + OFF_K; float* B_lds = (float*)(lds + OFF_B);
    float* ws = (float*)(lds + OFF_WS) + wid * 64; float* li_l = ws, * al_l = ws + 32;
    float m_reg = -1e30f, l_reg = 0; f32x16 o[4] = {};
    const int sr = tid >> 4, sc = (tid & 15) * 8, vst0 = v_st(sr, sc), vst1 = v_st(32 + sr, sc), kws = KSWZ(sr, sc * 2);
    const int vb0 = (int)(uintptr_t)V_lds + v_rd_base(lane);
    const char* ql = lds + OFF_QL + wid * 8192 + lane * 16;
#define RESC(a) do { if (__any((a) < 1.f)) { if (hi == 0) al_l[r32] = (a); asm volatile("s_waitcnt lgkmcnt(0)" ::: "memory");              \
                     for (int d_ = 0; d_ < 4; ++d_) for (int r = 0; r < 16; ++r) o[d_][r] *= al_l[crow(r, hi)]; } } while (0)
#define KBASE(t) ((j_hi - 1 - (t)) * KVBLK)
#define ACT(t) (wid < cur.nvw && KBASE(t) <= qlo + QBLK - 1 && j_hi - 1 - (t) >= jlw)
#define MASKT(P0_, P1_, t) do { const int kb_ = KBASE(t); if (ACT(t) && kb_ + KVBLK - 1 > qlo) mask_tile(P0_, P1_, qm - kb_); } while (0)
    f32x16 pA0, pA1, pB0, pB1; float mnA, mnB, alA, alB; bf16x8 pa0, pa1, pa2, pa3;
    SWRITE_HV(0); SBAR();
    if (NT > 1) SLOAD_H(cur, KBASE(1));
    SBAR(); qkt<0>(pA0, pA1, K_lds, r32, hi, ql, ACT(0));
    MASKT(pA0, pA1, 0); partialSM(pA0, pA1, m_reg, mnA, alA, B_lds, hi);
    if (NT > 1) { VMW(); SWRITE_H(1); }
    __syncthreads();
#define HALF_STEP(PX0, PX1, mnX, alX, PY0, PY1, alY, t, KB, VB, SB) do {                                                      \
        SBAR(); qkt<KB>(PX0, PX1, K_lds, r32, hi, ql, ACT(t));                                                         \
        finishSM(PY0, PY1, alY, l_reg, pa0, pa1, pa2, pa3); SBAR();                                                           \
        if ((t) + 1 < NT) { SLOAD_H(cur, KBASE((t) + 1)); SBAR(); }                                                           \
        pv_tile<VB>(o, vb0, pa0, pa1, pa2, pa3, ACT((t) - 1)); MASKT(PX0, PX1, (t)); partialSM(PX0, PX1, m_reg, mnX, alX, B_lds + (KB) * 64, hi);   \
        __syncthreads();                                                                                                      \
        if ((t) + 1 < NT) { VMW(); SWRITE_H(SB); }                                                                            \
        RESC(alX); __syncthreads(); } while (0)
    int t = 1;
    for (; t + 1 < NT && t < 5; t += 2) {
        HALF_STEP(pB0, pB1, mnB, alB, pA0, pA1, alA, t, 1, 0, 0);
        HALF_STEP(pA0, pA1, mnA, alA, pB0, pB1, alB, t + 1, 0, 1, 1);
    }
    if (t == 5 && cur.nvw == NW && NT > 7) {
        float mv = m_reg > -1e29f ? m_reg : 3e38f;
#pragma unroll
        for (int o_ = 1; o_ < 64; o_ <<= 1) mv = fminf(mv, __shfl_xor(mv, o_));
        float* mm = (float*)(lds + OFF_Q + 16);
        if (lane == 0) mm[wid] = mv;
        asm volatile("s_waitcnt lgkmcnt(0)" ::: "memory"); __syncthreads();
        float mmin = mm[0];
#pragma unroll
        for (int w_ = 1; w_ < NW; ++w_) mmin = fminf(mmin, mm[w_]);
        if (mmin < 1e38f) { const int p1 = cur.P0 > 0 ? cur.P0 : 0; int jl = first_tile_above(BS.B + cur.bo + 63, cur.bref - (BS.thr2 - mmin), p1 >> 6, lane);
            if (jl < cur.jlo) jl = cur.jlo; int ntn = j_hi - jl; if (ntn < 5) ntn = 5; if (ntn < NT) NT = ntn;
            if (mv < 1e38f) jlw = first_tile_above(BS.B + cur.bo + 63, cur.bref - (BS.thr2 - mv), p1 >> 6, lane); }
    }
    for (; t + 1 < NT; t += 2) {
        HALF_STEP(pB0, pB1, mnB, alB, pA0, pA1, alA, t, 1, 0, 0);
        HALF_STEP(pA0, pA1, mnA, alA, pB0, pB1, alB, t + 1, 0, 1, 1);
    }
    const bool even = (NT & 1) == 0;
    if (even) { SBAR(); qkt<1>(pB0, pB1, K_lds, r32, hi, ql, ACT(NT - 1)); SBAR(); }
    { const int ozt = opaque_zero(); const int sr = (tid >> 4) + ozt, sc = (tid & 15) * 8;
      SLOAD_H(nxt, (nxt.jhi - 1) * KVBLK); }
    SBAR();
    finishSM(pA0, pA1, alA, l_reg, pa0, pa1, pa2, pa3); SBAR();
    pv_tile<0>(o, vb0, pa0, pa1, pa2, pa3, ACT(even ? NT - 2 : NT - 1));
    if (even) { MASKT(pB0, pB1, NT - 1); partialSM(pB0, pB1, m_reg, mnB, alB, B_lds + 64, hi); __syncthreads(); RESC(alB);
        finishSM(pB0, pB1, alB, l_reg, pa0, pa1, pa2, pa3); SBAR(); pv_tile<1>(o, vb0, pa0, pa1, pa2, pa3, ACT(NT - 1)); }
    SBAR(); VMW(); SWRITE_HK(0); SBAR();
    if (hi == 0) li_l[r32] = l_reg; asm volatile("s_waitcnt lgkmcnt(0)" ::: "memory");
    float rli[16];
#pragma unroll
    for (int r = 0; r < 16; ++r) { const float lv = li_l[crow(r, hi)]; rli[r] = lv > 0.f ? __builtin_amdgcn_rcpf(lv) : 0.f; }
    const int ozq = opaque_zero(); bf16x8 tq[8];
    { const bf16_t* qn = BS.Q + nxt.qo + (size_t)(wid * QBLK + r32 + ozq) * PITCH + hi * 8;
#pragma unroll
      for (int d0 = 0; d0 < 8; ++d0) tq[d0] = load8(qn + d0 * 16); }
    if (wid < cur.nvw) {
        const int oz = opaque_zero(); bf16_t* Ow = BS.O + cur.qo + (size_t)(wid * QBLK) * PITCH + oz; const bf16_t* Gw = BS.G + cur.qo + (size_t)(wid * QBLK) * PITCH + oz;
        float* tl = (float*)(lds + OFF_QL + wid * 8192);
#pragma unroll
        for (int ps = 0; ps < 2; ++ps) {
#pragma unroll
            for (int rr = 0; rr < 8; ++rr) { const int r = ps * 8 + rr, lrow = (rr & 3) + 8 * (rr >> 2) + 4 * hi;
#pragma unroll
                for (int d0 = 0; d0 < 4; ++d0) tl[lrow * 128 + d0 * 32 + r32] = o[d0][r] * rli[r]; }
            asm volatile("s_waitcnt lgkmcnt(0)" ::: "memory");
#pragma unroll
            for (int it = 0; it < 4; ++it) { const int ch = it * 64 + lane, lrow = ch >> 4, c8 = (ch & 15) * 8; const size_t go = (size_t)(16 * ps + lrow) * PITCH + c8;
                const f32x4 a = *(const f32x4*)(tl + lrow * 128 + c8), b = *(const f32x4*)(tl + lrow * 128 + c8 + 4);
                const u32x4 gv = *(const u32x4*)(Gw + go);
                f32x4 g0, g1; g0[0] = __uint_as_float(gv[0] << 16); g0[1] = __uint_as_float(gv[0] & 0xffff0000u); g0[2] = __uint_as_float(gv[1] << 16); g0[3] = __uint_as_float(gv[1] & 0xffff0000u);
                g1[0] = __uint_as_float(gv[2] << 16); g1[1] = __uint_as_float(gv[2] & 0xffff0000u); g1[2] = __uint_as_float(gv[3] << 16); g1[3] = __uint_as_float(gv[3] & 0xffff0000u);
                const f32x4 y0 = a * g0, y1 = b * g1; u32x4 w; w.x = cvt_pk_bf16(y0[0], y0[1]); w.y = cvt_pk_bf16(y0[2], y0[3]); w.z = cvt_pk_bf16(y1[0], y1[1]); w.w = cvt_pk_bf16(y1[2], y1[3]);
                *(u32x4*)(Ow + go) = w; }
            asm volatile("s_waitcnt lgkmcnt(0)" ::: "memory");
        }
    }
    { char* qlw = lds + OFF_QL + wid * 8192 + (lane + ozq) * 16;
#pragma unroll
      for (int d0 = 0; d0 < 8; ++d0) *reinterpret_cast<bf16x8*>(qlw + d0 * 1024) = tq[d0]; }
    __syncthreads();
#undef RESC
#undef KBASE
#undef MASKT
#undef ACT
#undef HALF_STEP
}
#undef ROWP
#undef VMW
#undef VMWN
#undef SLOAD_H
#undef SWRITE_HK
#undef SWRITE_HV
#undef SWRITE_H
}
constexpr size_t MiB = (size_t)1 << 20;
constexpr size_t WS_CTL = 0, CTL_ZERO_BYTES = 128 * 1024;
constexpr size_t WS_COS = 2 * MiB, WS_SIN = 11 * MiB, WS_BP = 20 * MiB, WS_BS = WS_BP + (size_t)HF * BP_LEN * 4, WS_LF = 24 * MiB;
constexpr size_t SZ_WFI = (size_t)8448 * DM * 2, SZ_WFO = (size_t)DM * DM * 2, SZ_WRI = (size_t)NRETIN * DM * 2, SZ_WRO = (size_t)DM * DVT * 2, SZ_WUP = (size_t)DFF * DM * 2, SZ_WDN = (size_t)DM * DFFP * 2;
constexpr size_t WS_WFI = 32 * MiB, WS_WFO = WS_WFI + 2 * SZ_WFI, WS_WRI = WS_WFO + 2 * SZ_WFO, WS_WRO = WS_WRI + 2 * SZ_WRI, WS_WUP = WS_WRO + 2 * SZ_WRO, WS_WDN = WS_WUP + 4 * SZ_WUP, WS_WEND = WS_WDN + 4 * SZ_WDN;
static_assert(WS_WEND <= 500 * MiB, "weights map");
constexpr size_t WS_H = 500 * MiB, WS_XN = 638 * MiB, WS_R = 708 * MiB;
constexpr size_t R_Q = WS_R, R_K = WS_R + 70 * MiB, R_V = WS_R + 204 * MiB, R_G = WS_R + 338 * MiB;
constexpr size_t R_U = WS_R;
constexpr size_t R_SG = WS_R, R_AP = WS_R + 138 * MiB, R_BT = WS_R + 276 * MiB, R_KRN = WS_R + 536 * MiB, R_KTP = WS_R + 605 * MiB, R_OB = R_KRN, R_APS = WS_R + 674 * MiB, R_BTS = WS_R + 694 * MiB, R_KTS = WS_R + 734 * MiB;
constexpr size_t WS_SLAB = WS_R + 750 * MiB, WS_END = WS_SLAB + 64 * MiB;
static_assert((size_t)NSLAB * SLAB_ROWS * DM * 4 <= 64 * MiB, "slab");
static_assert((size_t)MROWS * DM * 4 <= 138 * MiB && (size_t)KB_ROWS * DM * 2 <= 134 * MiB && (size_t)8 * 65 * 512 * 512 * 2 <= 260 * MiB && (size_t)MROWS * DFFP * 2 <= 280 * MiB, "ws sizes");
constexpr int CW_BAR = 4096, CW_ATTN = 16384, CW_SCAN = 20480;

constexpr int RING_BYTES = 131072, XL_OFF = RING_BYTES  , MISC_OFF = RING_BYTES + 8192, LDS_BYTES = 147456;

#define RLX_AGENT __ATOMIC_RELAXED, __HIP_MEMORY_SCOPE_AGENT
#define LDS_WAIT() asm volatile("s_waitcnt lgkmcnt(0)" ::: "memory")
#define VM_WAIT() asm volatile("s_waitcnt vmcnt(0)" ::: "memory")

#define XB_TMO      128
#define XB_XCNT(j)  (256  + 64 * (j))
#define XB_XSUB(j)  (1280 + 64 * (j))
#define XB_XGEN(j)  (2304 + 64 * (j))
#define XB_TOP      3328
#define XB_TOPGEN   3392
#define XCD_BAR_WORDS 3456
#define XB_SPIN_CAP (1u << 20)
__device__ __forceinline__ unsigned xb_ld(unsigned* p)              { return __hip_atomic_load(p, __ATOMIC_RELAXED, __HIP_MEMORY_SCOPE_AGENT); }
__device__ __forceinline__ unsigned xb_add(unsigned* p, unsigned v) { return __hip_atomic_fetch_add(p, v, __ATOMIC_RELAXED, __HIP_MEMORY_SCOPE_AGENT); }
__device__ __forceinline__ unsigned xb_xcc_id() { return (unsigned)__builtin_amdgcn_s_getreg((3 << 11) | 20) & 0xFu; }
#define XB_SPIN(cond, bar) do { unsigned _sp = 0; while (cond) { __builtin_amdgcn_s_sleep(1); \
    if ((++_sp & 255u) == 0u) { if (xb_ld(&(bar)[XB_TMO])) break; if (_sp > XB_SPIN_CAP) { atomicAdd(&(bar)[XB_TMO], 1u); break; } } } } while (0)
struct XcdBarrier { unsigned* bar; unsigned x; volatile LAS unsigned* st; };
__device__ __forceinline__ XcdBarrier xcd_barrier_post(unsigned* bar, volatile LAS unsigned* st, const bool t0) {
    XcdBarrier b; b.bar = bar; b.x = xb_xcc_id(); b.st = st;
    if (t0) (void)xb_add(&bar[XB_XCNT(b.x)], 1u);
    return b;
}
__device__ __forceinline__ void xcd_barrier_complete(unsigned* bar, unsigned x, unsigned& nloc, unsigned& nx) {
    const unsigned G = gridDim.x * gridDim.y * gridDim.z;
    unsigned sum, cnt, mine, sp = 0u;
    for (;;) {
        sum = 0u; cnt = 0u; mine = 0u;
#pragma unroll
        for (unsigned j = 0; j < 16; ++j) { const unsigned c = xb_ld(&bar[XB_XCNT(j)]); sum += c; cnt += (c > 0u) ? 1u : 0u; mine = (j == x) ? c : mine; }
        if (sum == G) break;
        __builtin_amdgcn_s_sleep(1);
        if ((++sp & 255u) == 0u) { if (xb_ld(&bar[XB_TMO])) break; if (sp > XB_SPIN_CAP) { atomicAdd(&bar[XB_TMO], 1u); break; } }
    }
    nloc = mine > 0u ? mine : 1u; nx = cnt > 0u ? cnt : 1u;
}
__device__ __forceinline__ void xcd_barrier(const XcdBarrier& b, const bool t0) {
    asm volatile("s_waitcnt vmcnt(0)" ::: "memory");
    __syncthreads();
    if (t0) {
        unsigned* bar = b.bar;
        __builtin_amdgcn_s_waitcnt(0);
        unsigned nloc = b.st[0], nx = b.st[1];
        if (nloc == 0u) { xcd_barrier_complete(bar, b.x, nloc, nx); b.st[0] = nloc; b.st[1] = nx; }
        const unsigned old = xb_add(&bar[XB_XSUB(b.x)], 1u);
        const unsigned gen = old / nloc;
        if (old + 1u == (gen + 1u) * nloc) {
            __builtin_amdgcn_fence(__ATOMIC_RELEASE, "agent");
            asm volatile("s_waitcnt vmcnt(0)" ::: "memory");
            const unsigned og = xb_add(&bar[XB_TOP], 1u);
            const unsigned tg = og / nx;
            if (og + 1u == (tg + 1u) * nx) xb_add(&bar[XB_TOPGEN], 1u);
            else XB_SPIN(xb_ld(&bar[XB_TOPGEN]) == tg, bar);
            __builtin_amdgcn_fence(__ATOMIC_ACQUIRE, "agent");
            xb_add(&bar[XB_XGEN(b.x)], 1u);
            asm volatile("s_waitcnt vmcnt(0)" ::: "memory");
        } else {
            XB_SPIN(xb_ld(&bar[XB_XGEN(b.x)]) == gen, bar);
            __builtin_amdgcn_fence(__ATOMIC_ACQUIRE, "agent");
            asm volatile("s_waitcnt vmcnt(0)" ::: "memory");
        }
    }
    __syncthreads();
}

#define NORM_ROWS(body) do { \
    if (ngw == 2048 && slab) { \
        if (gw < SLAB_ROWS) { { const int row = SLAB_ROW0 + gw; body } for (int row = gw; row < 5 * SLAB_ROWS; row += SLAB_ROWS) { body } } \
        else for (int row = 5 * SLAB_ROWS + (gw - SLAB_ROWS); row < SLAB_ROW0; row += 2048 - SLAB_ROWS) { body } \
    } else for (int row = gw; row < MROWS; row += ngw) { body } } while (0)
__device__ __forceinline__ void norm_rows_bf16(float* h, const float* gain, bf16_t* xn, const float* slab, int gw, int ngw) {
    const int lane = lane_id_opaque();
    f32x4 gv[8];
#pragma unroll
    for (int j = 0; j < 8; ++j) gv[j] = ((const f32x4*)gain)[lane + 64 * j];
    NORM_ROWS({
        u32x2* xr = (u32x2*)((bf16_t*)h + (size_t)row * DM) + lane; f32x4 v[8]; float s = 0.f;
        _Pragma("unroll") for (int j = 0; j < 8; ++j) { const u32x2 hw = xr[64 * j]; v[j][0] = __uint_as_float(hw.x << 16); v[j][1] = __uint_as_float(hw.x & 0xffff0000u); v[j][2] = __uint_as_float(hw.y << 16); v[j][3] = __uint_as_float(hw.y & 0xffff0000u); }
        if (slab && row >= SLAB_ROW0) {
            _Pragma("unroll") for (int p = 0; p < NSLAB; ++p) { const u32x2* sr = (const u32x2*)((const bf16_t*)slab + ((size_t)p * SLAB_ROWS + (row - SLAB_ROW0)) * DM) + lane;
                _Pragma("unroll") for (int j = 0; j < 8; ++j) { const u32x2 w = sr[64 * j]; v[j][0] += __uint_as_float(w.x << 16); v[j][1] += __uint_as_float(w.x & 0xffff0000u); v[j][2] += __uint_as_float(w.y << 16); v[j][3] += __uint_as_float(w.y & 0xffff0000u); } }
            _Pragma("unroll") for (int j = 0; j < 8; ++j) { u32x2 hw; hw.x = cvt_pk_bf16(v[j][0], v[j][1]); hw.y = cvt_pk_bf16(v[j][2], v[j][3]); xr[64 * j] = hw; }
        }
        _Pragma("unroll") for (int j = 0; j < 8; ++j) s += (v[j][0] * v[j][0] + v[j][1] * v[j][1]) + (v[j][2] * v[j][2] + v[j][3] * v[j][3]);
        const float rs = 1.0f / sqrtf(wave_sum(s) * (1.0f / DM) + EPS);
        u32x2* o = (u32x2*)(xn + (size_t)row * DM) + lane;
        _Pragma("unroll") for (int j = 0; j < 8; ++j) { const f32x4 y = v[j] * rs * gv[j]; u32x2 w; w.x = cvt_pk_bf16(y[0], y[1]); w.y = cvt_pk_bf16(y[2], y[3]); o[64 * j] = w; }
    });
}
__device__ __forceinline__ void norm_rows_out(const float* h, const float* gain, float* out, const float* slab, int gw, int ngw) {
    const int lane = lane_id_opaque();
    f32x4 gv[8];
#pragma unroll
    for (int j = 0; j < 8; ++j) gv[j] = ((const f32x4*)gain)[lane + 64 * j];
    NORM_ROWS({
        if (!(row >= ROW_PAD && row < ROW_P0 + NMETA)) {
        float* dst = row < ROW_PAD ? out + O_YS + (size_t)row * DM : out + O_YP + (size_t)(row - ROW_P0 - NMETA) * DM;
        const u32x2* xr = (const u32x2*)((const bf16_t*)h + (size_t)row * DM) + lane; f32x4 v[8]; float s = 0.f;
        _Pragma("unroll") for (int j = 0; j < 8; ++j) { const u32x2 hw = xr[64 * j]; v[j][0] = __uint_as_float(hw.x << 16); v[j][1] = __uint_as_float(hw.x & 0xffff0000u); v[j][2] = __uint_as_float(hw.y << 16); v[j][3] = __uint_as_float(hw.y & 0xffff0000u); }
        if (row >= SLAB_ROW0) {
            _Pragma("unroll") for (int p = 0; p < NSLAB; ++p) { const u32x2* sr = (const u32x2*)((const bf16_t*)slab + ((size_t)p * SLAB_ROWS + (row - SLAB_ROW0)) * DM) + lane;
                _Pragma("unroll") for (int j = 0; j < 8; ++j) { const u32x2 w = sr[64 * j]; v[j][0] += __uint_as_float(w.x << 16); v[j][1] += __uint_as_float(w.x & 0xffff0000u); v[j][2] += __uint_as_float(w.y << 16); v[j][3] += __uint_as_float(w.y & 0xffff0000u); } }
        }
        _Pragma("unroll") for (int j = 0; j < 8; ++j) s += (v[j][0] * v[j][0] + v[j][1] * v[j][1]) + (v[j][2] * v[j][2] + v[j][3] * v[j][3]);
        const float rs = 1.0f / sqrtf(wave_sum(s) * (1.0f / DM) + EPS);
        _Pragma("unroll") for (int j = 0; j < 8; ++j) ((f32x4*)dst)[lane + 64 * j] = v[j] * rs * gv[j];
        }
    });
}
__device__ __forceinline__ void transpose_item(const float* W, int ldw, int nblk, bf16_t* WT, int ldt, LAS float* scr, int item, int lane) {
    const int kb = item / nblk, nb = item % nblk, k0 = 64 * kb, n0 = 32 * nb;
    f32x4 t[8];
#pragma unroll
    for (int i = 0; i < 8; ++i) t[i] = *(const f32x4*)(W + (size_t)(k0 + 8 * i + (lane >> 3)) * ldw + n0 + 4 * (lane & 7));
#pragma unroll
    for (int i = 0; i < 8; ++i) { LAS float* d = scr + (8 * i + (lane >> 3)) * 33 + 4 * (lane & 7); d[0] = t[i][0]; d[1] = t[i][1]; d[2] = t[i][2]; d[3] = t[i][3]; }
    LDS_WAIT(); asm volatile("" ::: "memory");
    const int c = lane & 7;
#pragma unroll
    for (int j = 0; j < 4; ++j) { const int n = (lane >> 3) + 8 * j; const LAS float* s = scr + (8 * c) * 33 + n;
        u32x4 o; o.x = cvt_pk_bf16(s[0 * 33], s[1 * 33]); o.y = cvt_pk_bf16(s[2 * 33], s[3 * 33]); o.z = cvt_pk_bf16(s[4 * 33], s[5 * 33]); o.w = cvt_pk_bf16(s[6 * 33], s[7 * 33]);
        *(u32x4*)(WT + (size_t)(n0 + n) * ldt + k0 + 8 * c) = o; }
    LDS_WAIT(); asm volatile("" ::: "memory");
}
__device__ __forceinline__ void sincos_d(double a, float& sv, float& cv) {
    const double n = __builtin_rint(a * 0.63661977236758134308);
    double r = __builtin_fma(-n, 1.57079632679489655800e+00, a); r = __builtin_fma(-n, 6.12323399573676603587e-17, r);
    const double z = r * r;
    const double sp = r * (1.0 + z * (-1.0 / 6 + z * (1.0 / 120 + z * (-1.0 / 5040 + z * (1.0 / 362880 + z * (-1.0 / 39916800 + z * (1.0 / 6227020800.0)))))));
    const double cp = 1.0 + z * (-0.5 + z * (1.0 / 24 + z * (-1.0 / 720 + z * (1.0 / 40320 + z * (-1.0 / 3628800 + z * (1.0 / 479001600 + z * (-1.0 / 87178291200.0)))))));
    const int q = ((int)(long long)n) & 3;
    const double s = (q & 1) ? cp : sp, c = (q & 1) ? sp : cp;
    sv = (float)((q & 2) ? -s : s); cv = (float)(((q + 1) & 2) ? -c : c);
}
__device__ __forceinline__ void prologue_phase(const float* const* in, unsigned char* ws, LAS unsigned char* lds, int gw, int ngw, int wave) {
    const int lane = lane_id_opaque();
    LAS float* scr = (LAS float*)(lds + wave * 16384);
    constexpr int I_FI = 32 * 256, I_FO = 32 * 64, I_RI = 32 * 384, I_RO = 64 * 64, I_UP = 32 * 256, I_DN = 128 * 64;
    constexpr int NITEMS = 2 * I_FI + 2 * I_FO + 2 * I_RI + 2 * I_RO + 4 * I_UP + 4 * I_DN;
    for (int it = gw; it < NITEMS; it += ngw) {
        int r = it;
        if (r < 2 * I_FI) { const int j = r / I_FI; transpose_item(in[10] + (size_t)j * DM * NFOXIN, NFOXIN, 256, (bf16_t*)(ws + WS_WFI + j * SZ_WFI), DM, scr, r % I_FI, lane); continue; } r -= 2 * I_FI;
        if (r < 2 * I_FO) { const int j = r / I_FO; transpose_item(in[14] + (size_t)j * DM * DM, DM, 64, (bf16_t*)(ws + WS_WFO + j * SZ_WFO), DM, scr, r % I_FO, lane); continue; } r -= 2 * I_FO;
        if (r < 2 * I_RI) { const int j = r / I_RI; transpose_item(in[15] + (size_t)j * DM * NRETIN, NRETIN, 384, (bf16_t*)(ws + WS_WRI + j * SZ_WRI), DM, scr, r % I_RI, lane); continue; } r -= 2 * I_RI;
        if (r < 2 * I_RO) { const int j = r / I_RO; transpose_item(in[17] + (size_t)j * DVT * DM, DM, 64, (bf16_t*)(ws + WS_WRO + j * SZ_WRO), DVT, scr, r % I_RO, lane); continue; } r -= 2 * I_RO;
        if (r < 4 * I_UP) { const int l = r / I_UP; transpose_item(in[18] + (size_t)l * DM * DFF, DFF, 256, (bf16_t*)(ws + WS_WUP + l * SZ_WUP), DM, scr, r % I_UP, lane); continue; } r -= 4 * I_UP;
        { const int l = r / I_DN; transpose_item(in[19] + (size_t)l * DFF * DM, DM, 64, (bf16_t*)(ws + WS_WDN + l * SZ_WDN), DFFP, scr, r % I_DN, lane); }
    }
    const int gt = gw * 64 + lane, ngt = ngw * 64;
    for (int e = gt; e < 2 * 16 * DM; e += ngt) { const int j = e / (16 * DM), c = (e / DM) & 15, k = e % DM;
        ((bf16_t*)(ws + WS_WFI + j * SZ_WFI))[(size_t)(8192 + c) * DM + k] = (bf16_t)(cvt_pk_bf16(in[10][(size_t)j * DM * NFOXIN + (size_t)k * NFOXIN + 8192 + c], 0.f) & 0xffffu); }
    for (int e = gt; e < 2 * 240 * DM / 8; e += ngt) { const int j = e / (240 * DM / 8), o = e % (240 * DM / 8);
        ((u32x4*)(ws + WS_WFI + j * SZ_WFI + (size_t)8208 * DM * 2))[o] = (u32x4){0u, 0u, 0u, 0u}; }
    float* h = (float*)(ws + WS_H); bf16_t* xn = (bf16_t*)(ws + WS_XN);
    { f32x4 gv[8];
#pragma unroll
      for (int j = 0; j < 8; ++j) gv[j] = ((const f32x4*)in[7])[lane + 64 * j];
      for (int row = gw; row < MROWS; row += ngw) { u32x2* d = (u32x2*)((bf16_t*)h + (size_t)row * DM) + lane;
        const float* s = row < ROW_PAD ? in[1] + (size_t)row * DM : (row < ROW_P0 ? nullptr : (row < ROW_P0 + NMETA ? in[6] + (size_t)(row - ROW_P0) * DM : in[0] + (size_t)(row - ROW_P0 - NMETA) * DM));
        f32x4 v[8]; float ss = 0.f;
#pragma unroll
        for (int j = 0; j < 8; ++j) { v[j] = s ? ((const f32x4*)s)[lane + 64 * j] : (f32x4){0.f, 0.f, 0.f, 0.f}; { u32x2 hw; hw.x = cvt_pk_bf16(v[j][0], v[j][1]); hw.y = cvt_pk_bf16(v[j][2], v[j][3]); d[64 * j] = hw; }
            ss += (v[j][0] * v[j][0] + v[j][1] * v[j][1]) + (v[j][2] * v[j][2] + v[j][3] * v[j][3]); }
        const float rs = 1.0f / sqrtf(wave_sum(ss) * (1.0f / DM) + EPS);
        u32x2* o = (u32x2*)(xn + (size_t)row * DM) + lane;
#pragma unroll
        for (int j = 0; j < 8; ++j) { const f32x4 y = v[j] * rs * gv[j]; u32x2 w; w.x = cvt_pk_bf16(y[0], y[1]); w.y = cvt_pk_bf16(y[2], y[3]); o[64 * j] = w; } } }
    float* COS = (float*)(ws + WS_COS); float* SIN = (float*)(ws + WS_SIN);
    for (int e = gt; e < LP * 128; e += ngt) { const int pos = e >> 7, c = e & 127;
        const float inv = (float)exp2(-(double)c * (13.287712379549449 / 128.0)); const float ang = (float)pos * inv; float sv, cv; sincos_d((double)ang, sv, cv);
        COS[e] = cv; SIN[e] = sv; }
}
__device__ __forceinline__ void fox_cache_phase(const float* ck, const float* cv, bf16_t* kbuf, bf16_t* vbuf, int gw, int ngw, bool convert) {
    const int lane = lane_id_opaque();
    if (convert) for (int t = gw; t < 2 * DB * PAST; t += ngw) { const int which = t >= DB * PAST, r = which ? t - DB * PAST : t;
        const f32x4* s = (const f32x4*)((which ? cv : ck) + (size_t)r * DM) + lane; u32x2* d = (u32x2*)((which ? vbuf : kbuf) + ((size_t)(r >> 10) * SKS + (r & 1023)) * DM) + lane;
#pragma unroll
        for (int j = 0; j < 8; ++j) { const f32x4 y = s[64 * j]; u32x2 w; w.x = cvt_pk_bf16(y[0], y[1]); w.y = cvt_pk_bf16(y[2], y[3]); d[64 * j] = w; } }
    for (int t = gw; t < 2 * 48; t += ngw) { u32x2* d = (u32x2*)((t >= 48 ? vbuf : kbuf) + (size_t)(KB_ROWS - 48 + (t % 48)) * DM) + lane;
#pragma unroll
        for (int j = 0; j < 8; ++j) d[64 * j] = (u32x2){0u, 0u}; }
}
__device__ __forceinline__ void scan_job(int wg, const float* lf, const float* clf, float* bP, float* bS, LAS double* sums, int wave) {
    const int lane = lane_id_opaque(), tid = wave * 64 + lane;
    constexpr double L2E = 1.4426950408889634;
    if (wg < 16) {
        const int head = wg, p0 = tid * 33; float v[33]; double s = 0.0;
#pragma unroll
        for (int i = 0; i < 33; ++i) { const int p = p0 + i; v[i] = p < LP ? lf[(size_t)(ROW_P0 + p) * HF + head] : 0.f; }
#pragma unroll
        for (int i = 0; i < 33; ++i) s += (double)v[i];
        double inc = s;
#pragma unroll
        for (int o = 1; o < 64; o <<= 1) { const double t = __shfl_up(inc, o); if (lane >= o) inc += t; }
        if (lane == 63) sums[wave] = inc;
        LDS_WAIT(); __syncthreads();
        double run = inc - s;
        for (int w = 0; w < wave; ++w) run += sums[w];
        float* out = bP + (size_t)head * BP_LEN;
#pragma unroll
        for (int i = 0; i < 33; ++i) { const int p = p0 + i; run += (double)v[i]; if (p < LP) out[p] = (float)(-run * L2E); }
        if (tid < BP_LEN - LP) out[LP + tid] = 0.f;
    } else {
        const int b = wg - 16, head = tid & 15, ck = tid >> 4, p0 = ck * 34; float v[34]; double s = 0.0;
#pragma unroll
        for (int i = 0; i < 34; ++i) { const int p = p0 + i; v[i] = p < PAST ? clf[((size_t)b * PAST + p) * HF + head] : lf[(size_t)(b * DS + p - PAST) * HF + head]; }
#pragma unroll
        for (int i = 0; i < 34; ++i) s += (double)v[i];
        sums[ck * 16 + head] = s;
        LDS_WAIT(); __syncthreads();
        double run = 0.0;
        for (int c = 0; c < ck; ++c) run += sums[c * 16 + head];
        float* out = bS + ((size_t)b * HF + head) * SKS;
#pragma unroll
        for (int i = 0; i < 34; ++i) { run += (double)v[i]; out[p0 + i] = (float)(-run * L2E); }
    }
}
__device__ __forceinline__ void scan_phase(const float* lf, const float* clf, float* bP, float* bS, LAS unsigned char* lds, int wave) {
    if ((int)blockIdx.x < 32) scan_job((int)blockIdx.x, lf, clf, bP, bS, (LAS double*)lds, wave);
}
#ifndef FA_CUT_BITS
#define FA_CUT_BITS 68
#endif
constexpr float FA_CUT = (float)FA_CUT_BITS + 2.0f;
__device__ __forceinline__ fa::BlockRef fa_ref(int item, const float* B, float thr, int lane) {
    fa::BlockRef r;
    if (item < 65 * HF) { const int blk = 64 - item / HF, head = item & 15;
        r.qo = (unsigned)((ROW_PAD + 256 * blk) * DM + head * DHF); r.ko = (unsigned)(KB_PROMPT0 * DM + head * DHF); r.bo = (unsigned)(head * BP_LEN);
        r.P0 = -240 + 256 * blk; const int p1 = r.P0 > 0 ? r.P0 : 0; r.bref = B[r.bo + p1]; r.jhi = (r.P0 + 255) / 64 + 1; r.nvw = 8;
        r.jlo = fa::first_tile_above(B + r.bo + 63, r.bref - thr, p1 >> 6, lane); }
    else { const int s = item - 65 * HF, b = s >> 4, head = s & 15;
        r.qo = (unsigned)((b * DS) * DM + head * DHF); r.ko = (unsigned)((b * SKS) * DM + head * DHF); r.bo = (unsigned)(HF * BP_LEN + (b * HF + head) * SKS);
        r.P0 = PAST; r.bref = B[r.bo + PAST]; r.jlo = 0; r.jhi = SKS / 64; r.nvw = 2; }
    return r;
}
__device__ __forceinline__ void attn_phase(unsigned* head_word, const bf16_t* qbuf, const bf16_t* kbuf, const bf16_t* vbuf, const bf16_t* gbuf, bf16_t* obuf, const float* B, const float* gq, const float* gk, char* ldsg, const int wave) {
    constexpr int NITEMS = 65 * HF + DB * HF; const int lane = lane_id_opaque(); const bool t0 = wave == 0 && lane == 0;
    volatile LAS unsigned* qw = (volatile LAS unsigned*)(LAS char*)(ldsg + fa::OFF_Q);

    float gm = fmaxf(fabsf(gq[lane]), fabsf(gq[lane + 64])), km = fmaxf(fabsf(gk[lane]), fabsf(gk[lane + 64]));
#pragma unroll
    for (int o = 1; o < 64; o <<= 1) { gm = fmaxf(gm, __shfl_xor(gm, o)); km = fmaxf(km, __shfl_xor(km, o)); }
    const float qb = 1.4426950408889634f * 11.313708498984761f * 1.02f * gm * km, thr = FA_CUT + 2.0f * qb;
    const fa::Bases BS{qbuf, kbuf, vbuf, gbuf, B, obuf, FA_CUT + qb};
#define FA_FETCH(dst) do { if (t0) qw[0] = __hip_atomic_fetch_add(head_word, 1u, RLX_AGENT); __syncthreads(); dst = __builtin_amdgcn_readfirstlane((int)qw[0]); } while (0)
    int ci; FA_FETCH(ci);
    if (ci < NITEMS) {
        fa::BlockRef cur = fa_ref(ci, B, thr, lane); fa::Seam S;
        fa::attn_prime(BS, cur, ldsg, S, wave);
        for (;;) { int ni; FA_FETCH(ni); const bool last = ni >= NITEMS; const fa::BlockRef nxt = last ? cur : fa_ref(ni, B, thr, lane);
            fa::attn_block(BS, cur, nxt, ldsg, S, wave); if (last) break; cur = nxt; }
    }
#undef FA_FETCH
}
__device__ __forceinline__ void ret_state_phase(const float* S0, bf16_t* BTS, LAS unsigned char* lds, int gw, int ngw, int wave) {
    const int lane = lane_id_opaque();
    LAS float* scr = (LAS float*)(lds + wave * 16384);
    for (int it = gw; it < DB * HR * 64; it += ngw) { const int mtx = it >> 6, b = mtx >> 3, head = mtx & 7, tile = b >> 2, bb = b & 3;
        transpose_item(S0 + (size_t)mtx * DKR * DVR, DVR, 16, BTS + (((size_t)head * 4 + tile) * 512) * 1280 + 256 + 256 * bb, 1280, scr, it & 63, lane); }
}
__device__ __forceinline__ void ret_transpose_phase(const bf16_t* krn, bf16_t* kTp, bf16_t* kTs, LAS unsigned char* lds, int gw, int ngw, int wave) {
    const int lane = lane_id_opaque();
    LAS unsigned char* scr = lds + wave * 16384;
    const int bx = (int)blockIdx.x; const bool bal = (ngw == 2048);
    const int s0 = !bal ? gw : (bx < 40 ? bx * 8 + wave : 320 + ((bx - 40) * 8 + wave) * 2), ns = (bal && bx >= 40) ? 2 : 1, st = bal ? 3776 : ngw;
    for (int kk = 0;; ++kk) { const int it = ns == 2 ? s0 + (kk & 1) + (kk >> 1) * st : s0 + kk * st; if (it >= NTILE * 4 * 32) break;
        const int pm = it >> 7, rg = (it >> 5) & 3, cg = it & 31, row0 = pm * 256 + rg * 64, col0 = cg * 64;
        u32x4 tt[8];
#pragma unroll
        for (int i = 0; i < 8; ++i) tt[i] = *(const u32x4*)(krn + (size_t)(row0 + 8 * i + (lane >> 3)) * DM + col0 + 8 * (lane & 7));
#pragma unroll
        for (int i = 0; i < 8; ++i) { LAS unsigned* d = (LAS unsigned*)(scr + (8 * i + (lane >> 3)) * 132 + 16 * (lane & 7)); d[0] = tt[i][0]; d[1] = tt[i][1]; d[2] = tt[i][2]; d[3] = tt[i][3]; }
        LDS_WAIT(); asm volatile("" ::: "memory");
#pragma unroll 8
        for (int i = 0; i < 32; ++i) { const int d = 2 * i + (lane >> 5), t2 = (lane & 31) * 2;
            const unsigned lo = *(const LAS unsigned short*)(scr + t2 * 132 + d * 2), hi = *(const LAS unsigned short*)(scr + (t2 + 1) * 132 + d * 2); const unsigned w = lo | (hi << 16);
            if (pm >= 4) *(unsigned*)(kTp + (size_t)(col0 + d) * MROWS + row0 + t2) = w;
            else { const int head = cg >> 2, dk = (cg & 3) * 64 + d;
#pragma unroll
                for (int bb = 0; bb < 4; ++bb) *(unsigned*)(kTs + ((((size_t)head * 4 + pm) * 4 + bb) * 256 + dk) * 256 + rg * 64 + t2) = bb == rg ? w : 0u; } }
        LDS_WAIT(); asm volatile("" ::: "memory");
    }
}
__device__ __forceinline__ void ret_prefix_phase(bf16_t* BT, float* out_state, int gw, int ngw) {
    const int gt = gw * 64 + lane_id_opaque(), ngt = ngw * 64;
    for (int e = gt; e < HR * 512 * 32; e += ngt) { const int head = e >> 14, dv = (e >> 5) & 511, dk8 = (e & 31) * 8;
        const float g256 = __builtin_amdgcn_exp2f(ret_lg2gamma(head) * 256.0f); float s[8];
#pragma unroll
        for (int k = 0; k < 8; ++k) s[k] = 0.f;
        bf16_t* p = BT + (((size_t)head * 65) * 512 + dv) * 512 + 256 + dk8;
        for (int b0 = 0; b0 < 65; b0 += 13) { u32x4 uu[13];
#pragma unroll
            for (int b = 0; b < 13; ++b) uu[b] = *(const u32x4*)(p + (size_t)(b0 + b) * 512 * 512);
#pragma unroll
            for (int b = 0; b < 13; ++b) { const u32x4 u = uu[b];
                u32x4 w; w.x = cvt_pk_bf16(s[0], s[1]); w.y = cvt_pk_bf16(s[2], s[3]); w.z = cvt_pk_bf16(s[4], s[5]); w.w = cvt_pk_bf16(s[6], s[7]); *(u32x4*)(p + (size_t)(b0 + b) * 512 * 512) = w;
#pragma unroll
                for (int k = 0; k < 4; ++k) { s[2 * k] = s[2 * k] * g256 + __uint_as_float(u[k] << 16); s[2 * k + 1] = s[2 * k + 1] * g256 + __uint_as_float(u[k] & 0xffff0000u); } } }
#pragma unroll
        for (int k = 0; k < 8; ++k) out_state[((size_t)head * DKR + dk8 + k) * DVR + dv] = s[k]; }
}
constexpr int N_PHASES = 37;
struct Args { const float* in[20]; float* out; unsigned char* ws; int ph_lo, ph_hi; };
__global__ void __launch_bounds__(512, 2) fwd_kernel(Args args) {
    extern __shared__ __attribute__((aligned(16))) unsigned char shm[];
    LAS unsigned char* lds = (LAS unsigned char*)shm;
    const int wave = __builtin_amdgcn_readfirstlane((int)threadIdx.x >> 6);
    unsigned char* const ws0 = args.ws; const float* const* const in0 = args.in; float* const out0 = args.out;
    unsigned* ctl = (unsigned*)(ws0 + WS_CTL);
#define LAUNDER() int lz_; asm volatile("s_mov_b32 %0, 0" : "=s"(lz_)); unsigned char* const ws = ws0 + lz_; const float* const* const in = in0 + lz_; float* const out = out0 + lz_; \
    const int G = (int)gridDim.x + lz_, bx = (int)blockIdx.x, vcu = (G % 8 == 0) ? (bx % 8) * (G / 8) + bx / 8 : bx, gw = vcu * 8 + wave, ngw = G * 8; (void)gw; (void)ngw; (void)in; (void)out
    for (int u = (int)threadIdx.x; u < (LDS_BYTES - MISC_OFF) / 4; u += 512) ((LAS unsigned*)(lds + MISC_OFF))[u] = 0u;
    __syncthreads();
    const bool fold_scan = ((int)gridDim.x == 256);
    const int lo = args.ph_lo, hi = args.ph_hi - ((fold_scan && args.ph_hi == N_PHASES) ? 2 : 0);
    XcdBarrier bar; bar.bar = ctl + CW_BAR; bar.x = 0; bar.st = (volatile LAS unsigned*)(lds + MISC_OFF);
    if (hi - lo > 1) bar = xcd_barrier_post(ctl + CW_BAR, (volatile LAS unsigned*)(lds + MISC_OFF), threadIdx.x == 0);
    int ph = 0;
#define PH_ON (lo <= ph && ph < hi)
#define HP ((float*)(ws + WS_H))
#define XNP ((bf16_t*)(ws + WS_XN))
#define SLABP ((float*)(ws + WS_SLAB))
#define PH_END do { if (lo <= ph && ph + 1 < hi) xcd_barrier(bar, wave == 0 && lane_id_opaque() == 0); ++ph; } while (0)

    if (PH_ON) { LAUNDER(); prologue_phase(in, ws, lds, gw, ngw, wave);
        fox_cache_phase(in[2], in[3], (bf16_t*)(ws + R_K), (bf16_t*)(ws + R_V), gw, ngw, G != 256);
    }
    PH_END;
    for (int i = 0; i < 4; ++i) {
        const int j = i >> 1;
        if ((i & 1) == 0) {
#define qbuf ((bf16_t*)(ws + R_Q))
#define kbuf ((bf16_t*)(ws + R_K))
#define vbuf ((bf16_t*)(ws + R_V))
#define gbuf ((bf16_t*)(ws + R_G))
#define lf ((float*)(ws + WS_LF))
#define bP ((float*)(ws + WS_BP))
#define bS ((float*)(ws + WS_BS))
            if (i > 0) {
            if (PH_ON) { LAUNDER(); norm_rows_bf16(HP, in[7] + (size_t)i * DM, XNP, SLABP, gw, ngw);
                fox_cache_phase(in[2] + (size_t)j * DB * PAST * DM, in[3] + (size_t)j * DB * PAST * DM, kbuf, vbuf, gw, ngw, G != 256); }
            PH_END;
            }
            if (PH_ON) { LAUNDER(); pg8::SchedFoxIn S{(const char*)XNP, (const char*)(ws + WS_WFI + j * SZ_WFI), G, bx};
                pg8::EpiFoxIn E{qbuf, kbuf, vbuf, gbuf, lf, in[11] + j * DHF, in[12] + j * DHF, in[13] + j * HF,
                                out + O_FKP + (size_t)j * LP * DM, out + O_FVP + (size_t)j * LP * DM, out + O_FLP + (size_t)j * LP * HF,
                                out + O_FKS + (size_t)j * DB * DS * DM, out + O_FVS + (size_t)j * DB * DS * DM, out + O_FLS + (size_t)j * DB * DS * HF, (LAS float*)(lds + XL_OFF), G == 256 ? in[2] + (size_t)j * DB * PAST * DM : nullptr, in[3] + (size_t)j * DB * PAST * DM,
                                fold_scan ? (unsigned*)(ws + WS_CTL) + CW_SCAN + 64 * j : nullptr, in[4] + (size_t)j * DB * PAST * HF, bP, bS};
                pg8::gemm_phase(lds, pg8::Shape{DM, DM}, S, E, wave);
                }
            PH_END;
            if (!fold_scan) {
            if (PH_ON) { LAUNDER(); scan_phase(lf, in[4] + (size_t)j * DB * PAST * HF, bP, bS, lds, wave); }
            PH_END;
            }
            if (PH_ON) { LAUNDER(); attn_phase((unsigned*)(ws + WS_CTL) + CW_ATTN + 64 * j, qbuf, kbuf, vbuf, gbuf, XNP, bP, in[11] + j * DHF, in[12] + j * DHF, (char*)shm, wave);
                }
            PH_END;
            if (PH_ON) { LAUNDER(); pg8::SchedResid S{(const char*)XNP, (const char*)(ws + WS_WFO + j * SZ_WFO), G, bx, (size_t)256 * DM * 2, (size_t)256 * DM * 2, DM / 64};
                pg8::EpiResid E{HP, SLABP}; pg8::gemm_phase(lds, pg8::Shape{DM, DM}, S, E, wave); }
            PH_END;
        } else {
#define sg ((bf16_t*)(ws + R_SG))
#define AP ((bf16_t*)(ws + R_AP))
#define BT ((bf16_t*)(ws + R_BT))
#define krn ((bf16_t*)(ws + R_KRN))
#define kTp ((bf16_t*)(ws + R_KTP))
#define ob ((bf16_t*)(ws + R_OB))
#define APS ((bf16_t*)(ws + R_APS))
#define BTS ((bf16_t*)(ws + R_BTS))
#define kTs ((bf16_t*)(ws + R_KTS))
            if (PH_ON) { LAUNDER(); norm_rows_bf16(HP, in[7] + (size_t)i * DM, XNP, i > 0 ? SLABP : nullptr, gw, ngw);
                if (G != 256) ret_state_phase(in[5] + (size_t)j * DB * HR * DKR * DVR, BTS, lds, gw, ngw, wave); }
            PH_END;
            if (PH_ON) { LAUNDER(); pg8::SchedRetIn S{(const char*)XNP, (const char*)(ws + WS_WRI + j * SZ_WRI), G, bx};
                pg8::EpiRetIn E{AP, APS, krn, sg, BT, BTS, (const float*)(ws + WS_COS), (const float*)(ws + WS_SIN)};
                pg8::gemm_phase(lds, pg8::Shape{DM, DM}, S, E, wave);
                }
            PH_END;
            if (PH_ON) { LAUNDER(); ret_transpose_phase(krn, kTp, kTs, lds, gw, ngw, wave); __syncthreads();
                pg8::SchedG1 S{(const char*)AP, (const char*)krn, G, bx}; pg8::EpiG1 E{AP, APS};
                pg8::gemm_phase(lds, pg8::Shape{512, DM}, S, E, wave);
                }
            PH_END;
            if (PH_ON) { LAUNDER(); { pg8::SchedG2p S{(const char*)BT, (const char*)kTp, G, bx}; pg8::EpiG2p E{BT}; pg8::gemm_phase(lds, pg8::Shape{512, MROWS}, S, E, wave); }
                }
            PH_END;
            if (PH_ON) { LAUNDER(); ret_prefix_phase(BT, out + O_RSP + (size_t)j * HR * DKR * DVR, gw, ngw); }
            PH_END;
            if (PH_ON) { LAUNDER(); { pg8::SchedG3p S{(const char*)AP, (const char*)BT, G, bx}; pg8::EpiG3 E{ob, sg, in[16] + (size_t)j * HR * DVR, (LAS float*)(lds + XL_OFF), (LAS float*)(lds + XL_OFF + 4096)}; pg8::gemm_phase(lds, pg8::Shape{512, 512}, S, E, wave); }
                { pg8::SchedG3s S{(const char*)APS, (const char*)BTS, G, bx}; pg8::EpiG3 E{ob, sg, in[16] + (size_t)j * HR * DVR, (LAS float*)(lds + XL_OFF), (LAS float*)(lds + XL_OFF + 4096)}; pg8::gemm_phase(lds, pg8::Shape{1280, 1280}, S, E, wave); }
                { const bool pool = (G == 256); const int Gs = pool ? 184 : G, cs = pool ? bx - 40 : bx;
                  if (cs >= 0 && cs < Gs) { pg8::SchedG2s S{(const char*)kTs, (const char*)BTS, Gs, cs}; pg8::EpiG2s E{in[5] + (size_t)j * DB * HR * DKR * DVR, out + O_RSS + (size_t)j * DB * HR * DKR * DVR};
                      pg8::gemm_phase(lds, pg8::Shape{256, 1280}, S, E, wave); } }
                }
            PH_END;
            if (PH_ON) { LAUNDER(); pg8::SchedResid S{(const char*)ob, (const char*)(ws + WS_WRO + j * SZ_WRO), G, bx, (size_t)256 * DVT * 2, (size_t)256 * DVT * 2, DVT / 64};
                pg8::EpiResid E{HP, SLABP}; pg8::gemm_phase(lds, pg8::Shape{DVT, DVT}, S, E, wave); }
            PH_END;
        }
#define ub ((bf16_t*)(ws + R_U))
        if (PH_ON) { LAUNDER(); norm_rows_bf16(HP, in[8] + (size_t)i * DM, XNP, SLABP, gw, ngw);
            }
        PH_END;
        if (PH_ON) { LAUNDER(); pg8::SchedSimple S{(const char*)XNP, (const char*)(ws + WS_WUP + i * SZ_WUP), NTILE, 32, G, bx, (size_t)256 * DM * 2, (size_t)256 * DM * 2, DM / 64};
            pg8::EpiUp E{ub}; pg8::gemm_phase(lds, pg8::Shape{DM, DM}, S, E, wave);
            if ((i & 1) == 0 && G == 256 && bx >= 160) ret_state_phase(in[5] + (size_t)(i >> 1) * DB * HR * DKR * DVR, (bf16_t*)(ws + R_BTS), lds, (bx - 160) * 8 + wave, 96 * 8, wave);
            }
        PH_END;
        if (PH_ON) { LAUNDER(); pg8::SchedResid S{(const char*)ub, (const char*)(ws + WS_WDN + i * SZ_WDN), G, bx, (size_t)256 * DFFP * 2, (size_t)256 * DFFP * 2, DFF / 64};
            pg8::EpiResid E{HP, SLABP}; pg8::gemm_phase(lds, pg8::Shape{DFFP, DFFP}, S, E, wave);
            }
        PH_END;
    }
    if (PH_ON) { LAUNDER(); norm_rows_out(HP, in[9], out, SLABP, gw, ngw); }
#undef PH_ON
#undef qbuf
#undef kbuf
#undef vbuf
#undef gbuf
#undef lf
#undef bP
#undef bS
#undef sg
#undef AP
#undef BT
#undef krn
#undef kTp
#undef ob
#undef APS
#undef BTS
#undef kTs
#undef ub
#undef HP
#undef XNP
#undef SLABP
#undef LAUNDER
#undef PH_END
}

#ifndef MK_PER_PHASE
#define MK_PER_PHASE 0
#endif
extern "C" void kernel_launch(void* const* d_in, const int* in_sizes, int n_in, void* d_out, int out_size, void* d_ws, size_t ws_size, hipStream_t stream) {
    static int grid = 0;
    if (grid == 0) {
        if (n_in != 20 || (size_t)out_size != O_END || ws_size < WS_END) { fprintf(stderr, "kernel_launch: unexpected shapes (n_in %d, out %d, ws %zu; need ws >= %zu)\n", n_in, out_size, ws_size, (size_t)WS_END); grid = -1; return; }
        int dev = 0, cus = 0, per_cu = 0;
        if (hipGetDevice(&dev) != hipSuccess || hipDeviceGetAttribute(&cus, hipDeviceAttributeMultiprocessorCount, dev) != hipSuccess) { grid = -1; return; }
        if (hipFuncSetAttribute((const void*)fwd_kernel, hipFuncAttributeMaxDynamicSharedMemorySize, LDS_BYTES) != hipSuccess) { fprintf(stderr, "kernel_launch: hipFuncSetAttribute failed\n"); grid = -1; return; }
        if (hipOccupancyMaxActiveBlocksPerMultiprocessor(&per_cu, (const void*)fwd_kernel, 512, LDS_BYTES) != hipSuccess || per_cu < 1) fprintf(stderr, "kernel_launch: occupancy query reports %d\n", per_cu);
        (void)hipGetLastError();
        grid = cus;
    }
    if (grid < 0) return;
    if (hipMemsetAsync((char*)d_ws + WS_CTL, 0, CTL_ZERO_BYTES, stream) != hipSuccess) return;
    Args a{};
    for (int i = 0; i < 20; ++i) a.in[i] = (const float*)d_in[i];
    a.out = (float*)d_out; a.ws = (unsigned char*)d_ws;
#if MK_PER_PHASE
    for (int p = 0; p < N_PHASES; ++p) { a.ph_lo = p; a.ph_hi = p + 1; hipLaunchKernelGGL(fwd_kernel, dim3(grid), dim3(512), LDS_BYTES, stream, a); }
#else
    a.ph_lo = 0; a.ph_hi = N_PHASES;
    hipLaunchKernelGGL(fwd_kernel, dim3(grid), dim3(512), LDS_BYTES, stream, a);
#endif
}
```

```cpp
#include <hip/hip_runtime.h>
#include <cstdio>
#include <cstdint>

#define LAS __attribute__((address_space(3)))
#define GAS __attribute__((address_space(1)))
typedef unsigned short bf16_t;
typedef short bf16x8 __attribute__((ext_vector_type(8)));
typedef short s16x4 __attribute__((ext_vector_type(4)));
typedef float f32x2 __attribute__((ext_vector_type(2)));
typedef float f32x4 __attribute__((ext_vector_type(4)));
typedef float f32x16 __attribute__((ext_vector_type(16)));
typedef unsigned u32x2 __attribute__((ext_vector_type(2)));
typedef unsigned u32x4 __attribute__((ext_vector_type(4)));
typedef GAS unsigned gu32;

constexpr int DM = 2048, SEQ = 16384, NMETA = 16, LP = NMETA + SEQ, DB = 16, DS = 64, PAST = 1024, SKS = PAST + DS;
constexpr int HF = 16, DHF = 128, HR = 8, DKR = 256, DVR = 512, DVT = 4096, DFF = 8192;
constexpr int NFOXIN = 4 * DM + HF, NRETIN = 12288;
constexpr int DFFP = DFF;
constexpr int ROW_PAD = 1024, ROW_P0 = 1264, MROWS = 17664, NTILE = 69;
constexpr int KB_ROWS = 34096;
constexpr int KB_PROMPT0 = 16384 + ROW_P0;
constexpr int BP_LEN = 16448;
constexpr float EPS = 1e-6f;
constexpr int SLAB_ROW0 = 16384, SLAB_ROWS = MROWS - SLAB_ROW0, NSLAB = 6;
constexpr size_t O_YP = 0, O_YS = O_YP + (size_t)SEQ * DM, O_FKP = O_YS + (size_t)DB * DS * DM, O_FVP = O_FKP + (size_t)2 * LP * DM, O_FLP = O_FVP + (size_t)2 * LP * DM,
                 O_RSP = O_FLP + (size_t)2 * LP * HF, O_FKS = O_RSP + (size_t)2 * HR * DKR * DVR, O_FVS = O_FKS + (size_t)2 * DB * DS * DM, O_FLS = O_FVS + (size_t)2 * DB * DS * DM,
                 O_RSS = O_FLS + (size_t)2 * DB * DS * HF, O_END = O_RSS + (size_t)2 * DB * HR * DKR * DVR;

__device__ __forceinline__ unsigned cvt_pk_bf16(float lo, float hi) { unsigned r; asm volatile("v_cvt_pk_bf16_f32 %0, %1, %2" : "=v"(r) : "v"(lo), "v"(hi)); return r; }
__device__ __forceinline__ float bf2f(unsigned short b) { return __uint_as_float(((unsigned)b) << 16); }
__device__ __forceinline__ u32x4 pack8f(f32x4 a, f32x4 b) { u32x4 w; w.x = cvt_pk_bf16(a[0], a[1]); w.y = cvt_pk_bf16(a[2], a[3]); w.z = cvt_pk_bf16(b[0], b[1]); w.w = cvt_pk_bf16(b[2], b[3]); return w; }
#ifndef ST16_MODE
#define ST16_MODE 0
#endif
__device__ __forceinline__ void st16(void* p, u32x4 v) {
#if ST16_MODE == 1
    asm volatile("global_store_dwordx4 %0, %1, off sc1" :: "v"(p), "v"(v) : "memory");
#elif ST16_MODE == 2
    asm volatile("global_store_dwordx4 %0, %1, off nt" :: "v"(p), "v"(v) : "memory");
#else
    *(u32x4*)p = v;
#endif
}
__device__ __forceinline__ float wave_sum(float v) {
#pragma unroll
    for (int o = 1; o < 64; o <<= 1) v += __shfl_xor(v, o);
    return v;
}
__device__ __forceinline__ int kv_rowmap(int r) { return r < ROW_PAD ? (r >> 6) * SKS + PAST + (r & 63) : 16384 + r; }
__device__ __forceinline__ int lane_id() { return (int)__builtin_amdgcn_mbcnt_hi(~0u, __builtin_amdgcn_mbcnt_lo(~0u, 0u)); }
__device__ __forceinline__ int lane_id_opaque() { int l; asm volatile("v_mbcnt_lo_u32_b32 %0, -1, 0\n\tv_mbcnt_hi_u32_b32 %0, -1, %0" : "=v"(l)); return l; }
__device__ __forceinline__ int opaque_zero() { int z; asm volatile("v_mov_b32 %0, 0" : "=v"(z)); return z; }
__device__ __forceinline__ float ret_lg2gamma(int h) { return __builtin_log2f(1.0f - __builtin_exp2f(-5.0f - (float)h)); }

namespace pg8 {
constexpr int BM = 256, BK = 64, HALF = 128, HTB = HALF * BK * 2, STAGE_BYTES = 8 * HTB, NXCD = 8;
__host__ __device__ __forceinline__ int lds_byte(int r, int c) { const int st = (r >> 4) * 2 + (c >> 5), rr = r & 15, cc = c & 31, ob = rr * 64 + cc * 2; return st * 1024 + (ob ^ (((ob >> 9) & 1) << 5)); }
__host__ __device__ __forceinline__ void stage_rc(int b, int& R, int& C) { const int st = b / 1024, sb = b % 1024, swz = sb ^ (((sb >> 9) & 1) << 5); R = (st >> 1) * 16 + swz / 64; C = (st & 1) * 32 + (swz % 64) / 2; }
__host__ __device__ __forceinline__ int perm32(int rho) { const int n = rho >> 4, i = rho & 15; return 8 * (i >> 2) + 4 * n + (i & 3); }

struct Unit { const char* a; const char* b; int pm, pn, kind, nt; };
struct Shape { int lda, ldb; };
template <int WG_M = 8>
__device__ __forceinline__ void tile_decode(int L, int nM, int nN, int& pm, int& pn) { constexpr int WGM = WG_M;
    const int nwg = nM * nN; int wgid = L;
    { const int q = nwg / NXCD, r = nwg % NXCD, xcd = wgid % NXCD, off = wgid / NXCD; wgid = (xcd < r ? xcd * (q + 1) : r * (q + 1) + (xcd - r) * q) + off; }
    const int nig = WGM * nN, gid = wgid / nig, fm = gid * WGM, gsz = (nM - fm) < WGM ? (nM - fm) : WGM;
    pm = fm + ((wgid % nig) % gsz); pn = (wgid % nig) / gsz;
}

template <class Epi, class Sched>
__device__ __forceinline__ void gemm_phase(LAS unsigned char* lds, const Shape g, const Sched& S, const Epi& E, const int wid) {
    const int lane = lane_id_opaque(), tid = wid * 64 + lane, wr = wid >> 2, wc = wid & 3, fr = lane & 15, fq = lane >> 4;
    unsigned voffA[2], voffB[2];
#pragma unroll
    for (int i = 0; i < 2; ++i) { int R, C; stage_rc(tid * 16 + i * 8192, R, C); const int Rb = Epi::PERM ? ((R & ~31) + perm32(R & 31)) : R;
        voffA[i] = (unsigned)(R * g.lda + C) * 2u; voffB[i] = (unsigned)(Rb * g.ldb + C) * 2u; }
    const size_t kstep = (size_t)(BK * 2);
    const size_t hstepA = (size_t)HALF * g.lda * 2, hstepB = (size_t)HALF * g.ldb * 2;
    const unsigned ldsw = (unsigned)wid * 1024u;
    const int aoff = lds_byte(wr * 64 + fr, fq * 8), boff = lds_byte(wc * 32 + fr, fq * 8);
#define PG8_SA(b, h) (((b) * 2 + (h)) * HTB)
#define PG8_SB(b, h) ((4 + (b) * 2 + (h)) * HTB)
#define PG8_STAGE(bufoff, gbase, voff) do { _Pragma("unroll") for (int _i = 0; _i < 2; ++_i) \
        __builtin_amdgcn_global_load_lds((const unsigned*)((const char*)(gbase) + (voff)[_i]), (LAS unsigned*)(lds + (bufoff) + ldsw + _i * 8192), 16, 0, 0); } while (0)
#define PG8_LDA(dst, b, h) do { _Pragma("unroll") for (int m = 0; m < 4; ++m) _Pragma("unroll") for (int k = 0; k < 2; ++k) dst[m][k] = *(const LAS bf16x8*)(lds + PG8_SA(b, h) + aoff + m * 2048 + k * 1024); } while (0)
#define PG8_LDB(dst, b, h) do { _Pragma("unroll") for (int n = 0; n < 2; ++n) _Pragma("unroll") for (int k = 0; k < 2; ++k) dst[n][k] = *(const LAS bf16x8*)(lds + PG8_SB(b, h) + boff + n * 2048 + k * 1024); } while (0)
#define PG8_MMA(ai, bj, At, Bt) do { __builtin_amdgcn_s_setprio(1); _Pragma("unroll") for (int m = 0; m < 4; ++m) _Pragma("unroll") for (int n = 0; n < 2; ++n) _Pragma("unroll") for (int k = 0; k < 2; ++k) \
        acc[ai][bj][m][n] = __builtin_amdgcn_mfma_f32_16x16x32_bf16(Bt[n][k], At[m][k], acc[ai][bj][m][n], 0, 0, 0); __builtin_amdgcn_s_setprio(0); } while (0)
#define PG8_WAIT_V(n) asm volatile("s_waitcnt vmcnt(" #n ")" ::: "memory")
#define PG8_WAIT_L(n) asm volatile("s_waitcnt lgkmcnt(" #n ")" ::: "memory")
#define PG8_BAR __builtin_amdgcn_s_barrier()
#define PG8_SCHED __builtin_amdgcn_sched_barrier(0)
    Unit cur, nxt; int ui = 0;
    if (!S.next(0, cur)) return;
    f32x4 acc[2][2][4][2];
#pragma unroll
    for (int a = 0; a < 2; ++a)
#pragma unroll
        for (int b = 0; b < 2; ++b)
#pragma unroll
            for (int m = 0; m < 4; ++m)
#pragma unroll
                for (int n = 0; n < 2; ++n) acc[a][b][m][n] = (f32x4){0.f, 0.f, 0.f, 0.f};
    bf16x8 At[4][2], B0[2][2], B1[2][2];
    const char* cA = cur.a; const char* cB = cur.b;
    PG8_STAGE(PG8_SB(0, 0), cB, voffB); PG8_STAGE(PG8_SB(0, 1), cB + hstepB, voffB); PG8_STAGE(PG8_SA(0, 0), cA, voffA); PG8_STAGE(PG8_SA(0, 1), cA + hstepA, voffA);
    if (wr == 1) PG8_BAR;
    PG8_WAIT_V(2); PG8_BAR;
    PG8_STAGE(PG8_SB(1, 0), cB + kstep, voffB); PG8_STAGE(PG8_SA(1, 0), cA + kstep, voffA); PG8_STAGE(PG8_SB(1, 1), cB + hstepB + kstep, voffB);
    PG8_WAIT_V(6); PG8_BAR;
    for (;;) {
        const bool has_next = S.next(ui + 1, nxt); const int nt = cur.nt;
        const char* nA = has_next ? nxt.a : cA; const char* nB = has_next ? nxt.b : cB;
#pragma nounroll
        for (int t = 0; t < nt; t += 2) {
            const bool last = (t == nt - 2);
            const char* a1 = cA + (size_t)(t + 1) * kstep;
            const char* a2 = last ? nA : cA + (size_t)(t + 2) * kstep; const char* b2 = last ? nB : cB + (size_t)(t + 2) * kstep;
            const char* a3 = a2 + kstep; const char* b3 = b2 + kstep;
            PG8_LDB(B0, 0, 0); PG8_LDB(B1, 0, 1); PG8_SCHED; PG8_LDA(At, 0, 0); PG8_STAGE(PG8_SA(1, 1), a1 + hstepA, voffA);
            PG8_WAIT_V(8); PG8_WAIT_L(0); PG8_BAR; PG8_MMA(0, 0, At, B0); PG8_MMA(0, 1, At, B1); PG8_BAR; PG8_SCHED;
            PG8_LDA(At, 0, 1); PG8_STAGE(PG8_SB(0, 0), b2, voffB); PG8_STAGE(PG8_SB(0, 1), b2 + hstepB, voffB); PG8_STAGE(PG8_SA(0, 0), a2, voffA);
            PG8_WAIT_V(8); PG8_WAIT_L(0); PG8_BAR; PG8_MMA(1, 0, At, B0); PG8_MMA(1, 1, At, B1); PG8_BAR; PG8_SCHED;
            PG8_LDB(B0, 1, 0); PG8_LDB(B1, 1, 1); PG8_SCHED; PG8_LDA(At, 1, 0); PG8_STAGE(PG8_SA(0, 1), a2 + hstepA, voffA);
            PG8_WAIT_V(8); PG8_WAIT_L(0); PG8_BAR; PG8_MMA(0, 0, At, B0); PG8_MMA(0, 1, At, B1); PG8_BAR; PG8_SCHED;
            PG8_LDA(At, 1, 1); PG8_STAGE(PG8_SB(1, 0), b3, voffB); PG8_STAGE(PG8_SB(1, 1), b3 + hstepB, voffB); PG8_STAGE(PG8_SA(1, 0), a3, voffA);
            PG8_WAIT_V(8); PG8_WAIT_L(0); PG8_BAR; PG8_MMA(1, 0, At, B0); PG8_MMA(1, 1, At, B1); PG8_BAR; PG8_SCHED;
        }
        if (wr == 0) PG8_BAR;
        E(acc, cur, wr, wc, fr, fq);
        E.side(ui, wid, lane);
        if (!has_next) break;
#pragma unroll
        for (int a = 0; a < 2; ++a)
#pragma unroll
            for (int b = 0; b < 2; ++b)
#pragma unroll
                for (int m = 0; m < 4; ++m)
#pragma unroll
                    for (int n = 0; n < 2; ++n) acc[a][b][m][n] = (f32x4){0.f, 0.f, 0.f, 0.f};
        cur = nxt; cA = nA; cB = nB; ++ui;
        if (wr == 1) PG8_BAR;
    }
    PG8_WAIT_V(0);
    PG8_BAR;
#undef PG8_SA
#undef PG8_SB
#undef PG8_STAGE
#undef PG8_LDA
#undef PG8_LDB
#undef PG8_MMA
#undef PG8_WAIT_V
#undef PG8_WAIT_L
#undef PG8_BAR
#undef PG8_SCHED
}
}
__device__ __forceinline__ void scan_job(int job, const float* lf, const float* clf, float* bP, float* bS, LAS double* sums, int wave);
namespace pg8 {
struct SchedFoxIn {
    const char* A; const char* Bt; int G, c;
    __device__ __forceinline__ bool next(int i, Unit& u) const {
        const long L = (long)i * G + c; if (L >= (long)NTILE * 33) return false;
        if (L < NTILE) { u.pm = (int)L; u.pn = 32; } else tile_decode<4>((int)L - NTILE, NTILE, 32, u.pm, u.pn);
        u.a = A + (size_t)u.pm * ((size_t)256 * DM * 2); u.b = Bt + (size_t)u.pn * ((size_t)256 * DM * 2); u.kind = 0; u.nt = DM / 64; return true; }
};
struct SchedSimple {
    const char* A; const char* Bt; int nM, nN, G, c; size_t astep, bstep; int nt;
    __device__ __forceinline__ bool next(int i, Unit& u) const {
        const long L = (long)i * G + c; if (L >= (long)nM * nN) return false;
        tile_decode<4>((int)L, nM, nN, u.pm, u.pn); u.a = A + (size_t)u.pm * astep; u.b = Bt + (size_t)u.pn * bstep; u.kind = 0; u.nt = nt; return true; }
};
struct SchedResid {
    const char* A; const char* Bt; int G, c; size_t astep, bstep; int nt;
    __device__ __forceinline__ bool next(int i, Unit& u) const {
        const long L = (long)i * G + c;
        if (L < 512) { tile_decode<4>((int)L, 64, 8, u.pm, u.pn);
            u.a = A + (size_t)u.pm * astep; u.b = Bt + (size_t)u.pn * bstep; u.kind = 0; u.nt = nt; return true; }
        const int s = (int)(L - 512); if (s >= 256) return false;
        int part, pmo, pno;
        if (G == 256) { const int g = 4 * (c & 7) + (c >> 6); if (g >= 30) return false; part = g / 5; pmo = g - 5 * part; pno = (c >> 3) & 7; }
        else { if (s >= 240) return false; const int q = s / 6; part = s - 6 * q; pmo = q >> 3; pno = q & 7; }
        const int e = nt >> 1, base = e / 6, r = e - 6 * base, k0 = part * base + (part < r ? part : r), np = base + (part < r ? 1 : 0);
        u.pm = 64 + pmo; u.pn = pno; u.kind = 1 + part; u.nt = 2 * np;
        u.a = A + (size_t)u.pm * astep + (size_t)k0 * 256; u.b = Bt + (size_t)u.pn * bstep + (size_t)k0 * 256; return true; }
};
struct SchedRetIn {
    const char* X; const char* W; int G, c;
    __device__ __forceinline__ bool next(int i, Unit& u) const {
        const long L = (long)i * G + c; constexpr int N0 = NTILE * 32, N1 = 16 * NTILE;
        if (L >= N0 + N1) return false;
        constexpr size_t ts = (size_t)256 * DM * 2;
        if (L < N0) { int pm, pn; tile_decode<4>((int)L, NTILE, 32, pm, pn); const int wt = pn < 16 ? pn : pn + 16;
            u.pm = pm; u.pn = wt; u.kind = 0; u.nt = DM / 64; u.a = X + (size_t)pm * ts; u.b = W + (size_t)wt * ts; }
        else { int pm, pn; tile_decode<4>((int)(L - N0), 16, NTILE, pm, pn); u.pm = pm; u.pn = pn; u.kind = 3; u.nt = DM / 64; u.a = W + (size_t)(16 + pm) * ts; u.b = X + (size_t)pn * ts; }
        return true; }
};
struct SchedG1 {
    const char* AP; const char* KRN; int G, c;
    __device__ __forceinline__ bool next(int i, Unit& u) const {
        const long L = (long)i * G + c; if (L >= NTILE * HR) return false;
        const int head = (int)L & 7, pm = (int)L >> 3; u.pm = pm; u.pn = 0; u.kind = head; u.nt = 4;
        u.a = AP + (((size_t)head * MROWS + (size_t)pm * 256) * 512 + 256) * 2; u.b = KRN + ((size_t)pm * 256 * DM + head * 256) * 2; return true; }
};
struct SchedG2p {
    const char* BT; const char* KTP; int G, c;
    __device__ __forceinline__ bool next(int i, Unit& u) const {
        const long L = (long)i * G + c; if (L >= HR * 65 * 2) return false;
        const int half = (int)L & 1, head = ((int)L >> 1) & 7, blk = (int)L >> 4; u.pm = blk; u.pn = half; u.kind = head; u.nt = 4;
        u.a = BT + ((((size_t)head * 65 + blk) * 512 + half * 256) * 512) * 2; u.b = KTP + ((size_t)head * 256 * MROWS + (size_t)(blk + 4) * 256) * 2; return true; }
};
struct SchedG2s {
    const char* KTS; const char* BTS; int G, c;
    __device__ __forceinline__ bool next(int i, Unit& u) const {
        const long L = (long)i * G + c; if (L >= DB * HR * 2) return false;
        const int half = (int)L & 1, head = ((int)L >> 1) & 7, b = (int)L >> 4, tile = b >> 2, bb = b & 3; u.pm = b; u.pn = half; u.kind = head; u.nt = 4;
        u.a = KTS + ((((size_t)head * 4 + tile) * 4 + bb) * 256 * 256) * 2; u.b = BTS + ((((size_t)head * 4 + tile) * 512 + half * 256) * 1280) * 2; return true; }
};
struct SchedG3p {
    const char* AP; const char* BT; int G, c;
    __device__ __forceinline__ bool next(int i, Unit& u) const {
        long p = (long)(i >> 1) * G + c;
        if (G == 256) { const int r = i >> 1;
            if (r == 0) p = c; else if (r == 1) { if (c >= 224) return false; p = 256 + c; } else if (r == 2) { if (c >= 40) return false; p = 480 + c; } else return false; }
        if (p >= HR * 65) return false;
        const int half = i & 1, head = (int)p & 7, blk = (int)p >> 3; u.pm = blk + 4; u.pn = half; u.kind = head; u.nt = 8;
        u.a = AP + (((size_t)head * MROWS + (size_t)(blk + 4) * 256) * 512) * 2; u.b = BT + ((((size_t)head * 65 + blk) * 512 + half * 256) * 512) * 2; return true; }
};
struct SchedG3s {
    const char* APS; const char* BTS; int G, c;
    __device__ __forceinline__ bool next(int i, Unit& u) const {
        const long p = (long)(i >> 1) * G + (G - 1 - c); if (p >= HR * 4) return false;
        const int half = i & 1, head = (int)p & 7, tile = (int)p >> 3; u.pm = tile; u.pn = half; u.kind = head; u.nt = 20;
        u.a = APS + (((size_t)head * 1024 + (size_t)tile * 256) * 1280) * 2; u.b = BTS + ((((size_t)head * 4 + tile) * 512 + half * 256) * 1280) * 2; return true; }
};

typedef const f32x4 (&AccRef)[2][2][4][2];

struct EpiResid { static constexpr bool PERM = true; float* H; float* SLAB;
    __device__ __forceinline__ void operator()(AccRef acc, const Unit& u, int wr, int wc, int fr, int fq) const {
        const int row0 = u.pm * BM + wr * 64 + fr + opaque_zero(), col0 = u.pn * BM + wc * 32 + 8 * fq + opaque_zero();
        if (u.kind == 0) {
#pragma unroll
            for (int ai = 0; ai < 2; ++ai) { u32x4 t[4][2];
#pragma unroll
                for (int m = 0; m < 4; ++m) { const bf16_t* rowp = (const bf16_t*)H + (size_t)(row0 + ai * HALF + m * 16) * DM + col0;
#pragma unroll
                    for (int bj = 0; bj < 2; ++bj) t[m][bj] = *(const u32x4*)(rowp + bj * HALF); }
                asm volatile("" ::: "memory");
#pragma unroll
                for (int m = 0; m < 4; ++m) { bf16_t* rowp = (bf16_t*)H + (size_t)(row0 + ai * HALF + m * 16) * DM + col0;
#pragma unroll
                    for (int bj = 0; bj < 2; ++bj) { const u32x4 hw = t[m][bj]; f32x4 h0, h1;
                        h0[0] = __uint_as_float(hw[0] << 16); h0[1] = __uint_as_float(hw[0] & 0xffff0000u); h0[2] = __uint_as_float(hw[1] << 16); h0[3] = __uint_as_float(hw[1] & 0xffff0000u);
                        h1[0] = __uint_as_float(hw[2] << 16); h1[1] = __uint_as_float(hw[2] & 0xffff0000u); h1[2] = __uint_as_float(hw[3] << 16); h1[3] = __uint_as_float(hw[3] & 0xffff0000u);
                        *(u32x4*)(rowp + bj * HALF) = pack8f(h0 + acc[ai][bj][m][0], h1 + acc[ai][bj][m][1]); } } }
        } else {
            bf16_t* sl = (bf16_t*)SLAB + (size_t)(u.kind - 1) * SLAB_ROWS * DM;
#pragma unroll
            for (int ai = 0; ai < 2; ++ai)
#pragma unroll
                for (int m = 0; m < 4; ++m) { bf16_t* rowp = sl + (size_t)(row0 - SLAB_ROW0 + ai * HALF + m * 16) * DM + col0;
#pragma unroll
                    for (int bj = 0; bj < 2; ++bj) *(u32x4*)(rowp + bj * HALF) = pack8f(acc[ai][bj][m][0], acc[ai][bj][m][1]); }
        }
    }
    __device__ __forceinline__ void side(int, int, int) const {}
};
struct EpiUp { static constexpr bool PERM = true; bf16_t* U;
    __device__ __forceinline__ void operator()(AccRef acc, const Unit& u, int wr, int wc, int fr, int fq) const {
        const int row0 = u.pm * BM + wr * 64 + fr + opaque_zero(), col0 = u.pn * BM + wc * 32 + 8 * fq + opaque_zero();
#pragma unroll
        for (int ai = 0; ai < 2; ++ai)
#pragma unroll
            for (int m = 0; m < 4; ++m) { bf16_t* rowp = U + (size_t)(row0 + ai * HALF + m * 16) * DFFP + col0;
#pragma unroll
                for (int bj = 0; bj < 2; ++bj) { f32x4 v0 = acc[ai][bj][m][0], v1 = acc[ai][bj][m][1];
#pragma unroll
                    for (int j = 0; j < 4; ++j) { const float a = fmaxf(v0[j], 0.f), b = fmaxf(v1[j], 0.f); v0[j] = a * a; v1[j] = b * b; }
                    st16(rowp + bj * HALF, pack8f(v0, v1)); } }
    }
    __device__ __forceinline__ void side(int, int, int) const {}
};
__device__ __forceinline__ float log_sigmoid_f(float x) { return x >= 0.f ? -log1pf(__expf(-x)) : x - log1pf(__expf(x)); }
__device__ __forceinline__ float sigmoid_f(float x) { return 1.0f / (1.0f + __expf(-x)); }
struct EpiFoxIn { static constexpr bool PERM = true;
    bf16_t *qbuf, *kbuf, *vbuf, *gbuf; float* lf; const float *gq, *gk, *bfb; float *okp, *ovp, *olp, *oks, *ovs, *ols; LAS float* xl; const float *CK, *CV;
    unsigned* cnt; const float* clf; float *bPp, *bSp;
    __device__ __forceinline__ void operator()(AccRef acc, const Unit& u, int wr, int wc, int fr, int fq) const {
        const int kind = u.pn >> 3, rt0 = wr * 64 + fr + opaque_zero(), dcol = wc * 32 + 8 * fq + opaque_zero();
        if (kind <= 1) {
#pragma unroll
            for (int ai = 0; ai < 2; ++ai)
#pragma unroll
                for (int m = 0; m < 4; ++m)
#pragma unroll
                    for (int bj = 0; bj < 2; ++bj) { const f32x4 a = acc[ai][bj][m][0], b = acc[ai][bj][m][1];
                        float s = (a[0] * a[0] + a[1] * a[1]) + (a[2] * a[2] + a[3] * a[3]) + (b[0] * b[0] + b[1] * b[1]) + (b[2] * b[2] + b[3] * b[3]);
                        s += __shfl_xor(s, 16); s += __shfl_xor(s, 32);
                        if (fq == 0) xl[((ai * HALF + rt0 + m * 16) * 2 + bj) * 4 + wc] = s; }
            asm volatile("s_waitcnt lgkmcnt(0)" ::: "memory"); __builtin_amdgcn_s_barrier(); asm volatile("" ::: "memory");
            const float* g = kind == 0 ? gq : gk; const f32x4 g0 = *(const f32x4*)(g + dcol), g1 = *(const f32x4*)(g + dcol + 4);
#pragma unroll
            for (int ai = 0; ai < 2; ++ai)
#pragma unroll
                for (int m = 0; m < 4; ++m) { const int rt = ai * HALF + rt0 + m * 16, row = u.pm * BM + rt;
#pragma unroll
                    for (int bj = 0; bj < 2; ++bj) { const f32x4 pp = *(const LAS f32x4*)(xl + (rt * 2 + bj) * 4);
                        const float rs = __builtin_amdgcn_rsqf(((pp[0] + pp[1]) + (pp[2] + pp[3])) * (1.0f / 128.0f) + EPS);
                        const f32x4 v0 = acc[ai][bj][m][0] * rs * g0, v1 = acc[ai][bj][m][1] * rs * g1; const int colh = (u.pn & 7) * BM + bj * HALF + dcol;
                        if (kind == 0) *(u32x4*)(qbuf + (size_t)row * DM + colh) = pack8f(v0, v1);
                        else { *(u32x4*)(kbuf + (size_t)kv_rowmap(row) * DM + colh) = pack8f(v0, v1);
                            float* o = row < ROW_PAD ? oks + (size_t)row * DM + colh : (row >= ROW_P0 ? okp + (size_t)(row - ROW_P0) * DM + colh : nullptr);
                            if (o) { *(f32x4*)o = v0; *(f32x4*)(o + 4) = v1; } } } }
        } else if (kind == 2) {
#pragma unroll
            for (int ai = 0; ai < 2; ++ai)
#pragma unroll
                for (int m = 0; m < 4; ++m) { const int rt = ai * HALF + rt0 + m * 16, row = u.pm * BM + rt;
#pragma unroll
                    for (int bj = 0; bj < 2; ++bj) { const f32x4 v0 = acc[ai][bj][m][0], v1 = acc[ai][bj][m][1]; const int colh = (u.pn & 7) * BM + bj * HALF + dcol;
                        *(u32x4*)(vbuf + (size_t)kv_rowmap(row) * DM + colh) = pack8f(v0, v1);
                        float* o = row < ROW_PAD ? ovs + (size_t)row * DM + colh : (row >= ROW_P0 ? ovp + (size_t)(row - ROW_P0) * DM + colh : nullptr);
                        if (o) { *(f32x4*)o = v0; *(f32x4*)(o + 4) = v1; } } }
        } else if (kind == 3) {
#pragma unroll
            for (int ai = 0; ai < 2; ++ai)
#pragma unroll
                for (int m = 0; m < 4; ++m) { const int rt = ai * HALF + rt0 + m * 16, row = u.pm * BM + rt;
#pragma unroll
                    for (int bj = 0; bj < 2; ++bj) { f32x4 v0 = acc[ai][bj][m][0], v1 = acc[ai][bj][m][1]; const int colh = (u.pn & 7) * BM + bj * HALF + dcol;
#pragma unroll
                        for (int j = 0; j < 4; ++j) { v0[j] = sigmoid_f(v0[j]); v1[j] = sigmoid_f(v1[j]); }
                        *(u32x4*)(gbuf + (size_t)row * DM + colh) = pack8f(v0, v1); } }
        } else {
            if (wc == 0 && dcol < 16) {
#pragma unroll
                for (int ai = 0; ai < 2; ++ai)
#pragma unroll
                    for (int m = 0; m < 4; ++m) { const int rt = ai * HALF + rt0 + m * 16, row = u.pm * BM + rt;
#pragma unroll
                        for (int n = 0; n < 2; ++n) { const int hd = dcol + 4 * n; const f32x4 bb = *(const f32x4*)(bfb + hd); f32x4 v = acc[ai][0][m][n] + bb;
#pragma unroll
                            for (int j = 0; j < 4; ++j) v[j] = log_sigmoid_f(v[j]);
                            if (cnt) { unsigned long long* lp = (unsigned long long*)(lf + (size_t)row * HF + hd);
                                __hip_atomic_store(lp, (unsigned long long)__float_as_uint(v[0]) | ((unsigned long long)__float_as_uint(v[1]) << 32), __ATOMIC_RELAXED, __HIP_MEMORY_SCOPE_AGENT);
                                __hip_atomic_store(lp + 1, (unsigned long long)__float_as_uint(v[2]) | ((unsigned long long)__float_as_uint(v[3]) << 32), __ATOMIC_RELAXED, __HIP_MEMORY_SCOPE_AGENT); }
                            else *(f32x4*)(lf + (size_t)row * HF + hd) = v;
                            float* o = row < ROW_PAD ? ols + (size_t)row * HF + hd : (row >= ROW_P0 ? olp + (size_t)(row - ROW_P0) * HF + hd : nullptr);
                            if (o) *(f32x4*)o = v; } }
            }
            if (cnt) { asm volatile("s_waitcnt vmcnt(0)" ::: "memory"); __builtin_amdgcn_s_barrier(); asm volatile("" ::: "memory");
                if (wr == 0 && wc == 0 && fr == 0 && fq == 0) (void)__hip_atomic_fetch_add(cnt, 1u, __ATOMIC_RELAXED, __HIP_MEMORY_SCOPE_AGENT); }
        }
    }
    __device__ __forceinline__ void side(int ui, int wid, int lane) const {
        if (CK && ui < 8) {
#pragma unroll
            for (int q = 0; q < 2; ++q) { const int t = ((int)blockIdx.x * 8 + ui) * 16 + 2 * wid + q, which = t >> 14, r = t & 16383;
                const f32x4* s = (const f32x4*)((which ? CV : CK) + (size_t)r * DM) + lane; u32x2* d = (u32x2*)((which ? vbuf : kbuf) + ((size_t)(r >> 10) * SKS + (r & 1023)) * DM) + lane;
                f32x4 y[8];
#pragma unroll
                for (int j = 0; j < 8; ++j) y[j] = s[64 * j];
#pragma unroll
                for (int j = 0; j < 8; ++j) { u32x2 w; w.x = cvt_pk_bf16(y[j][0], y[j][1]); w.y = cvt_pk_bf16(y[j][2], y[j][3]); d[64 * j] = w; } }
        }
        if (cnt && ui == 7 && (int)blockIdx.x >= 229) {
            if (wid == 0 && lane == 0) { unsigned sp = 0u; while (__hip_atomic_load(cnt, __ATOMIC_RELAXED, __HIP_MEMORY_SCOPE_AGENT) < (unsigned)NTILE) { __builtin_amdgcn_s_sleep(1); if (++sp > (1u << 22)) break; } }
            __syncthreads(); __builtin_amdgcn_fence(__ATOMIC_ACQUIRE, "agent"); asm volatile("s_waitcnt vmcnt(0)" ::: "memory");
            const int j0 = (int)blockIdx.x - 229;
            scan_job(j0, lf, clf, bPp, bSp, (LAS double*)xl, wid);
            if (j0 + 27 < 32) { __syncthreads(); scan_job(j0 + 27, lf, clf, bPp, bSp, (LAS double*)xl, wid); }
        }
    }
};
struct EpiRetIn { static constexpr bool PERM = true;
    bf16_t *AP, *APS, *krn, *sg, *BT, *BTS; const float *COS, *SIN;
    __device__ __forceinline__ void operator()(AccRef acc, const Unit& u, int wr, int wc, int fr, int fq) const {
        const int rt0 = wr * 64 + fr + opaque_zero(), dcol = wc * 32 + 8 * fq + opaque_zero();
        if (u.kind == 3) {
            const int head = u.pm >> 1;
#pragma unroll
            for (int ai = 0; ai < 2; ++ai)
#pragma unroll
                for (int m = 0; m < 4; ++m) { const int rt = ai * HALF + rt0 + m * 16, dvl = (u.pm & 1) * 256 + rt;
#pragma unroll
                    for (int bj = 0; bj < 2; ++bj) { const int tk = bj * HALF + dcol; u32x4 w = pack8f(acc[ai][bj][m][0], acc[ai][bj][m][1]);
                        if (u.pn >= 4) { if (u.pn == 4 && tk < 240) w = (u32x4){0u, 0u, 0u, 0u};
                            *(u32x4*)(BT + ((((size_t)head * 65 + (u.pn - 4)) * 512 + dvl) * 512 + tk)) = w; }
                        else *(u32x4*)(BTS + ((((size_t)head * 4 + u.pn) * 512 + dvl) * 1280 + tk)) = w; } }
        } else if (u.pn < 16) {
            const bool isq = u.pn < 8; const int head = u.pn & 7; const float lg = ret_lg2gamma(head);
#pragma unroll
            for (int ai = 0; ai < 2; ++ai)
#pragma unroll
                for (int m = 0; m < 4; ++m) { const int rt = ai * HALF + rt0 + m * 16, row = u.pm * BM + rt;
                    const int pos = row < ROW_PAD ? NMETA + PAST + (row & 63) : (row >= ROW_P0 ? row - ROW_P0 : 0);
                    const float e = (float)((row < ROW_PAD ? (row & 63) : (row & 255)) + 1);
                    float f = isq ? __builtin_amdgcn_exp2f(lg * e) : 0.0625f * __builtin_amdgcn_exp2f(-lg * e);
                    if (!isq && row >= ROW_PAD && row < ROW_P0) f = 0.f;
                    f32x4 o1[2], o2[2];
#pragma unroll
                    for (int n = 0; n < 2; ++n) { const f32x4 cs = *(const f32x4*)(COS + (size_t)pos * 128 + dcol + 4 * n), sn = *(const f32x4*)(SIN + (size_t)pos * 128 + dcol + 4 * n);
                        const f32x4 x1 = acc[ai][0][m][n], x2 = acc[ai][1][m][n]; o1[n] = (x1 * cs - x2 * sn) * f; o2[n] = (x1 * sn + x2 * cs) * f; }
                    const u32x4 w1 = pack8f(o1[0], o1[1]), w2 = pack8f(o2[0], o2[1]);
                    if (isq) { bf16_t* d = AP + (((size_t)head * MROWS + row) * 512 + 256 + dcol); *(u32x4*)d = w1; *(u32x4*)(d + 128) = w2;
                        if (row < ROW_PAD) { bf16_t* ds = APS + (((size_t)head * 1024 + row) * 1280 + 256 + dcol); const int slot = (row >> 6) & 3; const u32x4 z = (u32x4){0u, 0u, 0u, 0u};
#pragma unroll
                            for (int s = 0; s < 4; ++s) { *(u32x4*)(ds + s * 256) = s == slot ? w1 : z; *(u32x4*)(ds + s * 256 + 128) = s == slot ? w2 : z; } } }
                    else { bf16_t* d = krn + ((size_t)row * DM + head * 256 + dcol); *(u32x4*)d = w1; *(u32x4*)(d + 128) = w2; } }
        } else {
#pragma unroll
            for (int ai = 0; ai < 2; ++ai)
#pragma unroll
                for (int m = 0; m < 4; ++m) { const int rt = ai * HALF + rt0 + m * 16, row = u.pm * BM + rt;
#pragma unroll
                    for (int bj = 0; bj < 2; ++bj) { f32x4 v0 = acc[ai][bj][m][0], v1 = acc[ai][bj][m][1];
#pragma unroll
                        for (int j = 0; j < 4; ++j) { v0[j] = v0[j] * sigmoid_f(v0[j]); v1[j] = v1[j] * sigmoid_f(v1[j]); }
                        *(u32x4*)(sg + (size_t)row * DVT + (u.pn - 32) * BM + bj * HALF + dcol) = pack8f(v0, v1); } }
        }
    }
    __device__ __forceinline__ void side(int, int, int) const {}
};
struct EpiG1 { static constexpr bool PERM = true; bf16_t *AP, *APS;
    __device__ __forceinline__ void operator()(AccRef acc, const Unit& u, int wr, int wc, int fr, int fq) const {
        const int rt0 = wr * 64 + fr + opaque_zero(), dcol = wc * 32 + 8 * fq + opaque_zero(), head = u.kind;
#pragma unroll
        for (int ai = 0; ai < 2; ++ai)
#pragma unroll
            for (int m = 0; m < 4; ++m) { const int i = ai * HALF + rt0 + m * 16, row = u.pm * BM + i;
#pragma unroll
                for (int bj = 0; bj < 2; ++bj) { const int j0 = bj * HALF + dcol; f32x4 v0 = acc[ai][bj][m][0], v1 = acc[ai][bj][m][1];
#pragma unroll
                    for (int jj = 0; jj < 4; ++jj) { const int ja = j0 + jj, jb = j0 + 4 + jj;
                        const bool oka = ja <= i && (u.pm >= 4 || (ja >> 6) == (i >> 6)), okb = jb <= i && (u.pm >= 4 || (jb >> 6) == (i >> 6));
                        v0[jj] = oka ? v0[jj] : 0.f; v1[jj] = okb ? v1[jj] : 0.f; }
                    bf16_t* d = u.pm >= 4 ? AP + (((size_t)head * MROWS + row) * 512 + j0) : APS + (((size_t)head * 1024 + row) * 1280 + j0);
                    *(u32x4*)d = pack8f(v0, v1); } }
    }
    __device__ __forceinline__ void side(int, int, int) const {}
};
struct EpiG2p { static constexpr bool PERM = true; bf16_t* BT;
    __device__ __forceinline__ void operator()(AccRef acc, const Unit& u, int wr, int wc, int fr, int fq) const {
        const int rt0 = wr * 64 + fr + opaque_zero(), dcol = wc * 32 + 8 * fq + opaque_zero(), head = u.kind; const float g256 = __builtin_amdgcn_exp2f(ret_lg2gamma(head) * 256.0f);
#pragma unroll
        for (int ai = 0; ai < 2; ++ai)
#pragma unroll
            for (int m = 0; m < 4; ++m) { const int dvl = u.pn * 256 + ai * HALF + rt0 + m * 16;
#pragma unroll
                for (int bj = 0; bj < 2; ++bj)
                    *(u32x4*)(BT + ((((size_t)head * 65 + u.pm) * 512 + dvl) * 512 + 256 + bj * HALF + dcol)) = pack8f(acc[ai][bj][m][0] * g256, acc[ai][bj][m][1] * g256); }
    }
    __device__ __forceinline__ void side(int, int, int) const {}
};
struct EpiG2s { static constexpr bool PERM = false; const float* S0; float* OUT;
    __device__ __forceinline__ void operator()(AccRef acc, const Unit& u, int wr, int wc, int fr, int fq) const {
        const int rt0 = wr * 64 + fr + opaque_zero(), col0 = u.pn * 256 + wc * 32 + 4 * fq + opaque_zero(), head = u.kind; const float g64 = __builtin_amdgcn_exp2f(ret_lg2gamma(head) * 64.0f);
        const size_t base = ((size_t)u.pm * HR + head) * DKR * DVR;
#pragma unroll
        for (int ai = 0; ai < 2; ++ai)
#pragma unroll
            for (int m = 0; m < 4; ++m) { const int dk = ai * HALF + rt0 + m * 16; const size_t ro = base + (size_t)dk * DVR + col0; f32x4 t[2][2];
#pragma unroll
                for (int bj = 0; bj < 2; ++bj)
#pragma unroll
                    for (int n = 0; n < 2; ++n) t[bj][n] = *(const f32x4*)(S0 + ro + bj * HALF + n * 16);
#pragma unroll
                for (int bj = 0; bj < 2; ++bj)
#pragma unroll
                    for (int n = 0; n < 2; ++n) *(f32x4*)(OUT + ro + bj * HALF + n * 16) = (t[bj][n] + acc[ai][bj][m][n]) * g64; }
    }
    __device__ __forceinline__ void side(int, int, int) const {}
};
struct EpiG3 { static constexpr bool PERM = true; bf16_t* OB; const bf16_t* SG; const float* GN; LAS float* xl; LAS float* xs;
    __device__ __forceinline__ void operator()(AccRef acc, const Unit& u, int wr, int wc, int fr, int fq) const {
        const int rt0 = wr * 64 + fr + opaque_zero(), dcol = wc * 32 + 8 * fq + opaque_zero(), head = u.kind;
#pragma unroll
        for (int ai = 0; ai < 2; ++ai)
#pragma unroll
            for (int m = 0; m < 4; ++m) { float s = 0.f;
#pragma unroll
                for (int bj = 0; bj < 2; ++bj) { const f32x4 a = acc[ai][bj][m][0], b = acc[ai][bj][m][1];
                    s += (a[0] * a[0] + a[1] * a[1]) + (a[2] * a[2] + a[3] * a[3]) + (b[0] * b[0] + b[1] * b[1]) + (b[2] * b[2] + b[3] * b[3]); }
                s += __shfl_xor(s, 16); s += __shfl_xor(s, 32);
                if (fq == 0) xl[(ai * HALF + rt0 + m * 16) * 4 + wc] = s; }
        asm volatile("s_waitcnt lgkmcnt(0)" ::: "memory"); __builtin_amdgcn_s_barrier(); asm volatile("" ::: "memory");
        if (u.pn == 0) {
#pragma unroll
            for (int ai = 0; ai < 2; ++ai)
#pragma unroll
                for (int m = 0; m < 4; ++m) { const int rt = ai * HALF + rt0 + m * 16, row = u.pm * BM + rt;
                    if (wc == 0 && fq == 0) { const f32x4 pp = *(const LAS f32x4*)(xl + rt * 4); xs[rt] = (pp[0] + pp[1]) + (pp[2] + pp[3]); }
#pragma unroll
                    for (int bj = 0; bj < 2; ++bj) *(u32x4*)(OB + (size_t)row * DVT + head * 512 + bj * HALF + dcol) = pack8f(acc[ai][bj][m][0], acc[ai][bj][m][1]); }
        } else {
            f32x4 gn[2][2][2];
#pragma unroll
            for (int hf = 0; hf < 2; ++hf)
#pragma unroll
                for (int bj = 0; bj < 2; ++bj) { const int cl = hf * 256 + bj * HALF + dcol; gn[hf][bj][0] = *(const f32x4*)(GN + head * DVR + cl); gn[hf][bj][1] = *(const f32x4*)(GN + head * DVR + cl + 4); }
            u32x4 gvv[1][2][2], ovv[1][2];
#define G3_LOAD(buf, g_) do { const size_t ro_ = (size_t)(u.pm * BM + ((g_) >> 2) * HALF + rt0 + ((g_) & 3) * 16) * DVT + head * 512 + dcol; \
                _Pragma("unroll") for (int hf = 0; hf < 2; ++hf) _Pragma("unroll") for (int bj = 0; bj < 2; ++bj) gvv[buf][hf][bj] = *(const u32x4*)(SG + ro_ + hf * 256 + bj * HALF); \
                _Pragma("unroll") for (int bj = 0; bj < 2; ++bj) ovv[buf][bj] = *(const u32x4*)(OB + ro_ + bj * HALF); } while (0)
#pragma unroll
            for (int g = 0; g < 8; ++g) { const int ai = g >> 2, m = g & 3, cb = 0, rt = ai * HALF + rt0 + m * 16, row = u.pm * BM + rt;
                G3_LOAD(0, g); asm volatile("" ::: "memory");
                const f32x4 pp = *(const LAS f32x4*)(xl + rt * 4);
                const float rs = 1.0f / sqrtf((((pp[0] + pp[1]) + (pp[2] + pp[3])) + xs[rt]) * (1.0f / DVR) + EPS);
#pragma unroll
                for (int hf = 0; hf < 2; ++hf)
#pragma unroll
                    for (int bj = 0; bj < 2; ++bj) { const int cl = hf * 256 + bj * HALF + dcol; bf16_t* op = OB + (size_t)row * DVT + head * 512 + cl;
                        const u32x4 gv = gvv[cb][hf][bj]; const f32x4 n0 = gn[hf][bj][0], n1 = gn[hf][bj][1];
                        f32x4 v0, v1;
                        if (hf == 1) { v0 = acc[ai][bj][m][0]; v1 = acc[ai][bj][m][1]; }
                        else { const u32x4 ov = ovv[cb][bj]; v0[0] = __uint_as_float(ov[0] << 16); v0[1] = __uint_as_float(ov[0] & 0xffff0000u); v0[2] = __uint_as_float(ov[1] << 16); v0[3] = __uint_as_float(ov[1] & 0xffff0000u);
                            v1[0] = __uint_as_float(ov[2] << 16); v1[1] = __uint_as_float(ov[2] & 0xffff0000u); v1[2] = __uint_as_float(ov[3] << 16); v1[3] = __uint_as_float(ov[3] & 0xffff0000u); }
                        f32x4 g0, g1; g0[0] = __uint_as_float(gv[0] << 16); g0[1] = __uint_as_float(gv[0] & 0xffff0000u); g0[2] = __uint_as_float(gv[1] << 16); g0[3] = __uint_as_float(gv[1] & 0xffff0000u);
                        g1[0] = __uint_as_float(gv[2] << 16); g1[1] = __uint_as_float(gv[2] & 0xffff0000u); g1[2] = __uint_as_float(gv[3] << 16); g1[3] = __uint_as_float(gv[3] & 0xffff0000u);
                        *(u32x4*)op = pack8f(v0 * rs * n0 * g0, v1 * rs * n1 * g1); } }
#undef G3_LOAD
        }
    }
    __device__ __forceinline__ void side(int, int, int) const {}
};
}
namespace fa {
constexpr int NW = 8, QBLK = 32, KVBLK = 64, QB = NW * QBLK, D = 128, PITCH = DM;
constexpr int SHM_V = KVBLK * D * 2, SHM_K = KVBLK * D * 2;
constexpr int OFF_K = 2 * SHM_V, OFF_WS = OFF_K + 2 * SHM_K, OFF_B = OFF_WS + NW * 64 * 4, OFF_Q = OFF_B + 2 * 64 * 4, OFF_QL = 68608  , LDS_BYTES = OFF_QL + NW * 8192;
static_assert(OFF_Q + 64 <= OFF_QL, "lds map");
constexpr float C2 = 0.08838834764831845f * 1.4426950408889634f, THR2 = 8.0f * 1.4426950408889634f;

#define KSWZ(row, colB) ((row) * 256 + ((colB) ^ (((row) & 7) << 4)))
#define SBAR() __builtin_amdgcn_sched_barrier(0)
__device__ __forceinline__ int v_st(int k, int c) { const int kk = (k & ~0xC) | ((k & 4) << 1) | ((k & 8) >> 1); return ((kk >> 3) * 4 + (c >> 5)) * 512 + ((kk & 7) * 32 + (c & 31)) * 2; }
__device__ __forceinline__ int v_rd_base(int lane) { return ((lane & 3) << 3) | (((lane >> 2) & 3) << 6) | (((lane >> 4) & 1) << 5) | (((lane >> 5) & 1) << 8); }
constexpr int v_rd_off(int d0, int ks, int half) { return d0 * 512 + ks * 4096 + half * 2048; }
__device__ __forceinline__ int crow(int r, int hi) { return (r & 3) + 8 * (r >> 2) + 4 * hi; }
__device__ __forceinline__ bf16x8 load8(const bf16_t* p) { return *reinterpret_cast<const bf16x8*>(p); }
__device__ __forceinline__ void mask_tile(f32x16& p0, f32x16& p1, int dq) {
    const float NEG = -__builtin_inff();
#pragma unroll
    for (int r = 0; r < 16; ++r) { const int c = (r & 3) + 8 * (r >> 2); if (dq - c < 0) p0[r] = NEG; if (dq - c - 32 < 0) p1[r] = NEG; }
}
__device__ __forceinline__ void partialSM(f32x16& p0, f32x16& p1, float& m_reg, float& mn, float& alpha, const float* bl, int hi) {
#pragma unroll
    for (int g = 0; g < 4; ++g) { const f32x4 b0 = *(const f32x4*)(bl + 8 * g + 4 * hi), b1 = *(const f32x4*)(bl + 32 + 8 * g + 4 * hi);
#pragma unroll
        for (int j = 0; j < 4; ++j) { p0[4 * g + j] = fmaf(p0[4 * g + j], C2, b0[j]); p1[4 * g + j] = fmaf(p1[4 * g + j], C2, b1[j]); } }
    float pmax = p0[0];
#pragma unroll
    for (int r = 1; r < 16; ++r) pmax = fmaxf(pmax, p0[r]);
#pragma unroll
    for (int r = 0; r < 16; ++r) pmax = fmaxf(pmax, p1[r]);
    { auto rr = __builtin_amdgcn_permlane32_swap(__float_as_uint(pmax), __float_as_uint(pmax), false, false);
      pmax = fmaxf(__uint_as_float(rr[0]), __uint_as_float(rr[1])); }
    if (__builtin_expect(__all(pmax - m_reg <= THR2), 1)) { mn = m_reg; alpha = 1.f; }
    else { mn = fmaxf(m_reg, pmax); alpha = __builtin_amdgcn_exp2f(m_reg - mn); m_reg = mn; }
#pragma unroll
    for (int r = 0; r < 16; ++r) { p0[r] = p0[r] - mn; p1[r] = p1[r] - mn; }
#pragma unroll
    for (int r = 0; r < 16; ++r) p0[r] = __builtin_amdgcn_exp2f(p0[r]);
}
__device__ __forceinline__ void finishSM(f32x16& p0, f32x16& p1, float alpha, float& l_reg, bf16x8& pa0, bf16x8& pa1, bf16x8& pa2, bf16x8& pa3) {
#pragma unroll
    for (int r = 0; r < 16; ++r) p1[r] = __builtin_amdgcn_exp2f(p1[r]);
    float ps = 0;
#pragma unroll
    for (int r = 0; r < 16; ++r) ps += p0[r];
#pragma unroll
    for (int r = 0; r < 16; ++r) ps += p1[r];
    { auto rr = __builtin_amdgcn_permlane32_swap(__float_as_uint(ps), __float_as_uint(ps), false, false);
      ps = __uint_as_float(rr[0]) + __uint_as_float(rr[1]); }
    l_reg = l_reg * alpha + ps;
#define PK4(P, B_, OUT) do { unsigned a0 = cvt_pk_bf16(P[B_+0], P[B_+1]), a1 = cvt_pk_bf16(P[B_+2], P[B_+3]);                          \
        unsigned b0 = cvt_pk_bf16(P[B_+4], P[B_+5]), b1 = cvt_pk_bf16(P[B_+6], P[B_+7]);                                             \
        auto r0 = __builtin_amdgcn_permlane32_swap(a0, b0, false, false); auto r1 = __builtin_amdgcn_permlane32_swap(a1, b1, false, false); \
        u32x4 w = {r0[0], r1[0], r0[1], r1[1]}; OUT = *reinterpret_cast<bf16x8*>(&w); } while (0)
    PK4(p0, 0, pa0); PK4(p0, 8, pa1); PK4(p1, 0, pa2); PK4(p1, 8, pa3);
#undef PK4
}
template <int KB>
__device__ __forceinline__ void qkt(f32x16& p0, f32x16& p1, const char* K_lds, int r32, int hi, const char* ql, bool act) {
    if (!act) { const float NEG = -__builtin_inff();
#pragma unroll
        for (int r = 0; r < 16; ++r) { p0[r] = NEG; p1[r] = NEG; } return; }
    p0 = f32x16{}; p1 = f32x16{};
    const char* kb[4];
#pragma unroll
    for (int dd = 0; dd < 4; ++dd) kb[dd] = K_lds + KB * SHM_K + KSWZ(r32, (dd * 16 + hi * 8) * 2);
#pragma unroll
    for (int d0 = 0; d0 < 8; ++d0) { const char* a = kb[d0 & 3] + (d0 >> 2) * 128;
        bf16x8 b0 = *reinterpret_cast<const bf16x8*>(a);
        bf16x8 b1 = *reinterpret_cast<const bf16x8*>(a + 32 * 256);
        const bf16x8 qv = *reinterpret_cast<const bf16x8*>(ql + d0 * 1024);
        p0 = __builtin_amdgcn_mfma_f32_32x32x16_bf16(b0, qv, p0, 0, 0, 0);
        p1 = __builtin_amdgcn_mfma_f32_32x32x16_bf16(b1, qv, p1, 0, 0, 0); }
}
template <int VB>
__device__ __forceinline__ void pv_tile(f32x16* o, int vb0, bf16x8 pa0, bf16x8 pa1, bf16x8 pa2, bf16x8 pa3, bool act) {
    if (!act) return;
#define TRRD(dst, off) asm volatile("ds_read_b64_tr_b16 %0, %1 offset:%2" : "=&v"(dst) : "v"(vb0), "i"(off) : "memory")
#define PV_D0(d0) do { s16x4 l0, l1, l2, l3, h0, h1, h2, h3; constexpr int b_ = VB * SHM_V + v_rd_off(d0, 0, 0); \
        TRRD(l0, b_); TRRD(h0, b_ + 2048); TRRD(l1, b_ + 4096); TRRD(h1, b_ + 6144); TRRD(l2, b_ + 8192); TRRD(h2, b_ + 10240); TRRD(l3, b_ + 12288); TRRD(h3, b_ + 14336); \
        asm volatile("s_waitcnt lgkmcnt(0)" ::: "memory"); SBAR();   \
        o[d0] = __builtin_amdgcn_mfma_f32_32x32x16_bf16(pa0, (bf16x8){l0[0], l0[1], l0[2], l0[3], h0[0], h0[1], h0[2], h0[3]}, o[d0], 0, 0, 0);   \
        o[d0] = __builtin_amdgcn_mfma_f32_32x32x16_bf16(pa1, (bf16x8){l1[0], l1[1], l1[2], l1[3], h1[0], h1[1], h1[2], h1[3]}, o[d0], 0, 0, 0);   \
        o[d0] = __builtin_amdgcn_mfma_f32_32x32x16_bf16(pa2, (bf16x8){l2[0], l2[1], l2[2], l2[3], h2[0], h2[1], h2[2], h2[3]}, o[d0], 0, 0, 0);   \
        o[d0] = __builtin_amdgcn_mfma_f32_32x32x16_bf16(pa3, (bf16x8){l3[0], l3[1], l3[2], l3[3], h3[0], h3[1], h3[2], h3[3]}, o[d0], 0, 0, 0); } while (0)
    PV_D0(0); PV_D0(1); PV_D0(2); PV_D0(3);
#undef PV_D0
#undef TRRD
}
__device__ __forceinline__ int first_tile_above(const float* bb, float cut, int jmax, int lane) {
    const int stride = (jmax >> 6) + 1; int t1 = (lane + 1) * stride - 1; if (t1 > jmax) t1 = jmax;
    const unsigned long long m1 = __ballot(bb[t1 * 64] > cut); const int l1 = m1 ? (int)__builtin_ctzll(m1) : 63;
    const int base = l1 * stride; int t2 = base + (lane < stride ? lane : stride - 1); if (t2 > jmax) t2 = jmax;
    const unsigned long long m2 = __ballot(bb[t2 * 64] > cut); const int l2 = m2 ? (int)__builtin_ctzll(m2) : stride - 1;
    int jl = base + l2; if (jl > jmax) jl = jmax; return __builtin_amdgcn_readfirstlane(jl); }
struct Bases { const bf16_t* Q; const bf16_t* K; const bf16_t* V; const bf16_t* G; const float* B; bf16_t* O; float thr2; };
struct BlockRef { unsigned qo, ko, bo; float bref; int P0, jlo, jhi, nvw; };
struct Seam { bf16x8 st_v0, st_v1, st_k0, st_k1; float st_b; };
#define ROWP(p, k0, rr) ((const bf16_t*)((const char*)((p) + (size_t)(k0) * PITCH) + (unsigned)(((rr) * PITCH + sc) * 2)))
#define VMW() asm volatile("s_waitcnt vmcnt(0)" ::: "memory")
#define VMWN(n) asm volatile("s_waitcnt vmcnt(%0)" :: "i"(n) : "memory")
#define SLOAD_H(R_, k0) do { S.st_v0 = load8(ROWP(BS.V + (R_).ko, k0, sr)); S.st_v1 = load8(ROWP(BS.V + (R_).ko, k0, 32 + sr));              \
                         S.st_k0 = load8(ROWP(BS.K + (R_).ko, k0, sr)); S.st_k1 = load8(ROWP(BS.K + (R_).ko, k0, 32 + sr)); if (tid < 64) S.st_b = (BS.B + (R_).bo)[(k0) + tid] - (R_).bref; } while (0)
#define SWRITE_HK(bf) do { *(bf16x8*)(K_lds + (bf) * SHM_K + kws) = S.st_k0; *(bf16x8*)(K_lds + (bf) * SHM_K + kws + 32 * 256) = S.st_k1; if (tid < 64) B_lds[(bf) * 64 + tid] = S.st_b; } while (0)
#define SWRITE_HV(bf) do { *(bf16x8*)(V_lds + (bf) * SHM_V + vst0) = S.st_v0; *(bf16x8*)(V_lds + (bf) * SHM_V + vst1) = S.st_v1; } while (0)
#define SWRITE_H(bf) do { SWRITE_HV(bf); SWRITE_HK(bf); } while (0)
__device__ __forceinline__ void attn_prime(const Bases& BS, const BlockRef& cur, char* lds, Seam& S, const int wid) {
    const int lane = lane_id_opaque(), tid = wid * 64 + lane, r32 = lane & 31, hi = lane >> 5;
    const int sr = tid >> 4, sc = (tid & 15) * 8, kws = KSWZ(sr, sc * 2); char* K_lds = lds + OFF_K; float* B_lds = (float*)(lds + OFF_B);
    { char* ql = lds + OFF_QL + wid * 8192 + lane * 16; const bf16_t* qn = BS.Q + cur.qo + (size_t)(wid * QBLK + r32) * PITCH + hi * 8; bf16x8 tq[8];
#pragma unroll
      for (int d0 = 0; d0 < 8; ++d0) tq[d0] = load8(qn + d0 * 16);
#pragma unroll
      for (int d0 = 0; d0 < 8; ++d0) *reinterpret_cast<bf16x8*>(ql + d0 * 1024) = tq[d0]; }
    SLOAD_H(cur, (cur.jhi - 1) * KVBLK); VMW(); SWRITE_HK(0);
    __syncthreads();
}
__device__ __forceinline__ void attn_block(const Bases& BS, const BlockRef& cur, const BlockRef& nxt, char* lds, Seam& S, const int wid) {
    const int lane = lane_id_opaque(), tid = wid * 64 + lane, r32 = lane & 31, hi = lane >> 5;
    const int j_hi = cur.jhi; int NT = cur.jhi - cur.jlo, jlw = 0;
    const int qlo = cur.P0 + wid * QBLK, qm = qlo + r32 - 4 * hi;
    char* V_lds = lds; char* K_lds = lds + OFF_K; float* B_lds = (float*)(lds + OFF_B);
    float* ws = (float*)(lds + OFF_WS) + wid * 64; float* li_l = ws, * al_l = ws + 32;
    float m_reg = -1e30f, l_reg = 0; f32x16 o[4] = {};
    const int sr = tid >> 4, sc = (tid & 15) * 8, vst0 = v_st(sr, sc), vst1 = v_st(32 + sr, sc), kws = KSWZ(sr, sc * 2);
    const int vb0 = (int)(uintptr_t)V_lds + v_rd_base(lane);
    const char* ql = lds + OFF_QL + wid * 8192 + lane * 16;
#define RESC(a) do { if (__any((a) < 1.f)) { if (hi == 0) al_l[r32] = (a); asm volatile("s_waitcnt lgkmcnt(0)" ::: "memory");              \
                     for (int d_ = 0; d_ < 4; ++d_) for (int r = 0; r < 16; ++r) o[d_][r] *= al_l[crow(r, hi)]; } } while (0)
#define KBASE(t) ((j_hi - 1 - (t)) * KVBLK)
#define ACT(t) (wid < cur.nvw && KBASE(t) <= qlo + QBLK - 1 && j_hi - 1 - (t) >= jlw)
#define MASKT(P0_, P1_, t) do { const int kb_ = KBASE(t); if (ACT(t) && kb_ + KVBLK - 1 > qlo) mask_tile(P0_, P1_, qm - kb_); } while (0)
    f32x16 pA0, pA1, pB0, pB1; float mnA, mnB, alA, alB; bf16x8 pa0, pa1, pa2, pa3;
    SWRITE_HV(0); SBAR();
    if (NT > 1) SLOAD_H(cur, KBASE(1));
    SBAR(); qkt<0>(pA0, pA1, K_lds, r32, hi, ql, ACT(0));
    MASKT(pA0, pA1, 0); partialSM(pA0, pA1, m_reg, mnA, alA, B_lds, hi);
    if (NT > 1) { VMW(); SWRITE_H(1); }
    __syncthreads();
#define HALF_STEP(PX0, PX1, mnX, alX, PY0, PY1, alY, t, KB, VB, SB) do {                                                      \
        SBAR(); qkt<KB>(PX0, PX1, K_lds, r32, hi, ql, ACT(t));                                                         \
        finishSM(PY0, PY1, alY, l_reg, pa0, pa1, pa2, pa3); SBAR();                                                           \
        if ((t) + 1 < NT) { SLOAD_H(cur, KBASE((t) + 1)); SBAR(); }                                                           \
        pv_tile<VB>(o, vb0, pa0, pa1, pa2, pa3, ACT((t) - 1)); MASKT(PX0, PX1, (t)); partialSM(PX0, PX1, m_reg, mnX, alX, B_lds + (KB) * 64, hi);   \
        __syncthreads();                                                                                                      \
        if ((t) + 1 < NT) { VMW(); SWRITE_H(SB); }                                                                            \
        RESC(alX); __syncthreads(); } while (0)
    int t = 1;
    for (; t + 1 < NT && t < 5; t += 2) {
        HALF_STEP(pB0, pB1, mnB, alB, pA0, pA1, alA, t, 1, 0, 0);
        HALF_STEP(pA0, pA1, mnA, alA, pB0, pB1, alB, t + 1, 0, 1, 1);
    }
    if (t == 5 && cur.nvw == NW && NT > 7) {
        float mv = m_reg > -1e29f ? m_reg : 3e38f;
#pragma unroll
        for (int o_ = 1; o_ < 64; o_ <<= 1) mv = fminf(mv, __shfl_xor(mv, o_));
        float* mm = (float*)(lds + OFF_Q + 16);
        if (lane == 0) mm[wid] = mv;
        asm volatile("s_waitcnt lgkmcnt(0)" ::: "memory"); __syncthreads();
        float mmin = mm[0];
#pragma unroll
        for (int w_ = 1; w_ < NW; ++w_) mmin = fminf(mmin, mm[w_]);
        if (mmin < 1e38f) { const int p1 = cur.P0 > 0 ? cur.P0 : 0; int jl = first_tile_above(BS.B + cur.bo + 63, cur.bref - (BS.thr2 - mmin), p1 >> 6, lane);
            if (jl < cur.jlo) jl = cur.jlo; int ntn = j_hi - jl; if (ntn < 5) ntn = 5; if (ntn < NT) NT = ntn;
            if (mv < 1e38f) jlw = first_tile_above(BS.B + cur.bo + 63, cur.bref - (BS.thr2 - mv), p1 >> 6, lane); }
    }
    for (; t + 1 < NT; t += 2) {
        HALF_STEP(pB0, pB1, mnB, alB, pA0, pA1, alA, t, 1, 0, 0);
        HALF_STEP(pA0, pA1, mnA, alA, pB0, pB1, alB, t + 1, 0, 1, 1);
    }
    const bool even = (NT & 1) == 0;
    if (even) { SBAR(); qkt<1>(pB0, pB1, K_lds, r32, hi, ql, ACT(NT - 1)); SBAR(); }
    { const int ozt = opaque_zero(); const int sr = (tid >> 4) + ozt, sc = (tid & 15) * 8;
      SLOAD_H(nxt, (nxt.jhi - 1) * KVBLK); }
    SBAR();
    finishSM(pA0, pA1, alA, l_reg, pa0, pa1, pa2, pa3); SBAR();
    pv_tile<0>(o, vb0, pa0, pa1, pa2, pa3, ACT(even ? NT - 2 : NT - 1));
    if (even) { MASKT(pB0, pB1, NT - 1); partialSM(pB0, pB1, m_reg, mnB, alB, B_lds + 64, hi); __syncthreads(); RESC(alB);
        finishSM(pB0, pB1, alB, l_reg, pa0, pa1, pa2, pa3); SBAR(); pv_tile<1>(o, vb0, pa0, pa1, pa2, pa3, ACT(NT - 1)); }
    SBAR(); VMW(); SWRITE_HK(0); SBAR();
    if (hi == 0) li_l[r32] = l_reg; asm volatile("s_waitcnt lgkmcnt(0)" ::: "memory");
    float rli[16];
#pragma unroll
    for (int r = 0; r < 16; ++r) { const float lv = li_l[crow(r, hi)]; rli[r] = lv > 0.f ? __builtin_amdgcn_rcpf(lv) : 0.f; }
    const int ozq = opaque_zero(); bf16x8 tq[8];
    { const bf16_t* qn = BS.Q + nxt.qo + (size_t)(wid * QBLK + r32 + ozq) * PITCH + hi * 8;
#pragma unroll
      for (int d0 = 0; d0 < 8; ++d0) tq[d0] = load8(qn + d0 * 16); }
    if (wid < cur.nvw) {
        const int oz = opaque_zero(); bf16_t* Ow = BS.O + cur.qo + (size_t)(wid * QBLK) * PITCH + oz; const bf16_t* Gw = BS.G + cur.qo + (size_t)(wid * QBLK) * PITCH + oz;
        float* tl = (float*)(lds + OFF_QL + wid * 8192);
#pragma unroll
        for (int ps = 0; ps < 2; ++ps) {
#pragma unroll
            for (int rr = 0; rr < 8; ++rr) { const int r = ps * 8 + rr, lrow = (rr & 3) + 8 * (rr >> 2) + 4 * hi;
#pragma unroll
                for (int d0 = 0; d0 < 4; ++d0) tl[lrow * 128 + d0 * 32 + r32] = o[d0][r] * rli[r]; }
            asm volatile("s_waitcnt lgkmcnt(0)" ::: "memory");
#pragma unroll
            for (int it = 0; it < 4; ++it) { const int ch = it * 64 + lane, lrow = ch >> 4, c8 = (ch & 15) * 8; const size_t go = (size_t)(16 * ps + lrow) * PITCH + c8;
                const f32x4 a = *(const f32x4*)(tl + lrow * 128 + c8), b = *(const f32x4*)(tl + lrow * 128 + c8 + 4);
                const u32x4 gv = *(const u32x4*)(Gw + go);
                f32x4 g0, g1; g0[0] = __uint_as_float(gv[0] << 16); g0[1] = __uint_as_float(gv[0] & 0xffff0000u); g0[2] = __uint_as_float(gv[1] << 16); g0[3] = __uint_as_float(gv[1] & 0xffff0000u);
                g1[0] = __uint_as_float(gv[2] << 16); g1[1] = __uint_as_float(gv[2] & 0xffff0000u); g1[2] = __uint_as_float(gv[3] << 16); g1[3] = __uint_as_float(gv[3] & 0xffff0000u);
                const f32x4 y0 = a * g0, y1 = b * g1; u32x4 w; w.x = cvt_pk_bf16(y0[0], y0[1]); w.y = cvt_pk_bf16(y0[2], y0[3]); w.z = cvt_pk_bf16(y1[0], y1[1]); w.w = cvt_pk_bf16(y1[2], y1[3]);
                *(u32x4*)(Ow + go) = w; }
            asm volatile("s_waitcnt lgkmcnt(0)" ::: "memory");
        }
    }
    { char* qlw = lds + OFF_QL + wid * 8192 + (lane + ozq) * 16;
#pragma unroll
      for (int d0 = 0; d0 < 8; ++d0) *reinterpret_cast<bf16x8*>(qlw + d0 * 1024) = tq[d0]; }
    __syncthreads();
#undef RESC
#undef KBASE
#undef MASKT
#undef ACT
#undef HALF_STEP
}
#undef ROWP
#undef VMW
#undef VMWN
#undef SLOAD_H
#undef SWRITE_HK
#undef SWRITE_HV
#undef SWRITE_H
}
constexpr size_t MiB = (size_t)1 << 20;
constexpr size_t WS_CTL = 0, CTL_ZERO_BYTES = 128 * 1024;
constexpr size_t WS_COS = 2 * MiB, WS_SIN = 11 * MiB, WS_BP = 20 * MiB, WS_BS = WS_BP + (size_t)HF * BP_LEN * 4, WS_LF = 24 * MiB;
constexpr size_t SZ_WFI = (size_t)8448 * DM * 2, SZ_WFO = (size_t)DM * DM * 2, SZ_WRI = (size_t)NRETIN * DM * 2, SZ_WRO = (size_t)DM * DVT * 2, SZ_WUP = (size_t)DFF * DM * 2, SZ_WDN = (size_t)DM * DFFP * 2;
constexpr size_t WS_WFI = 32 * MiB, WS_WFO = WS_WFI + 2 * SZ_WFI, WS_WRI = WS_WFO + 2 * SZ_WFO, WS_WRO = WS_WRI + 2 * SZ_WRI, WS_WUP = WS_WRO + 2 * SZ_WRO, WS_WDN = WS_WUP + 4 * SZ_WUP, WS_WEND = WS_WDN + 4 * SZ_WDN;
static_assert(WS_WEND <= 500 * MiB, "weights map");
constexpr size_t WS_H = 500 * MiB, WS_XN = 638 * MiB, WS_R = 708 * MiB;
constexpr size_t R_Q = WS_R, R_K = WS_R + 70 * MiB, R_V = WS_R + 204 * MiB, R_G = WS_R + 338 * MiB;
constexpr size_t R_U = WS_R;
constexpr size_t R_SG = WS_R, R_AP = WS_R + 138 * MiB, R_BT = WS_R + 276 * MiB, R_KRN = WS_R + 536 * MiB, R_KTP = WS_R + 605 * MiB, R_OB = R_KRN, R_APS = WS_R + 674 * MiB, R_BTS = WS_R + 694 * MiB, R_KTS = WS_R + 734 * MiB;
constexpr size_t WS_SLAB = WS_R + 750 * MiB, WS_END = WS_SLAB + 64 * MiB;
static_assert((size_t)NSLAB * SLAB_ROWS * DM * 4 <= 64 * MiB, "slab");
static_assert((size_t)MROWS * DM * 4 <= 138 * MiB && (size_t)KB_ROWS * DM * 2 <= 134 * MiB && (size_t)8 * 65 * 512 * 512 * 2 <= 260 * MiB && (size_t)MROWS * DFFP * 2 <= 280 * MiB, "ws sizes");
constexpr int CW_BAR = 4096, CW_ATTN = 16384, CW_SCAN = 20480;

constexpr int RING_BYTES = 131072, XL_OFF = RING_BYTES  , MISC_OFF = RING_BYTES + 8192, LDS_BYTES = 147456;

#define RLX_AGENT __ATOMIC_RELAXED, __HIP_MEMORY_SCOPE_AGENT
#define LDS_WAIT() asm volatile("s_waitcnt lgkmcnt(0)" ::: "memory")
#define VM_WAIT() asm volatile("s_waitcnt vmcnt(0)" ::: "memory")

#define XB_TMO      128
#define XB_XCNT(j)  (256  + 64 * (j))
#define XB_XSUB(j)  (1280 + 64 * (j))
#define XB_XGEN(j)  (2304 + 64 * (j))
#define XB_TOP      3328
#define XB_TOPGEN   3392
#define XCD_BAR_WORDS 3456
#define XB_SPIN_CAP (1u << 20)
__device__ __forceinline__ unsigned xb_ld(unsigned* p)              { return __hip_atomic_load(p, __ATOMIC_RELAXED, __HIP_MEMORY_SCOPE_AGENT); }
__device__ __forceinline__ unsigned xb_add(unsigned* p, unsigned v) { return __hip_atomic_fetch_add(p, v, __ATOMIC_RELAXED, __HIP_MEMORY_SCOPE_AGENT); }
__device__ __forceinline__ unsigned xb_xcc_id() { return (unsigned)__builtin_amdgcn_s_getreg((3 << 11) | 20) & 0xFu; }
#define XB_SPIN(cond, bar) do { unsigned _sp = 0; while (cond) { __builtin_amdgcn_s_sleep(1); \
    if ((++_sp & 255u) == 0u) { if (xb_ld(&(bar)[XB_TMO])) break; if (_sp > XB_SPIN_CAP) { atomicAdd(&(bar)[XB_TMO], 1u); break; } } } } while (0)
struct XcdBarrier { unsigned* bar; unsigned x; volatile LAS unsigned* st; };
__device__ __forceinline__ XcdBarrier xcd_barrier_post(unsigned* bar, volatile LAS unsigned* st, const bool t0) {
    XcdBarrier b; b.bar = bar; b.x = xb_xcc_id(); b.st = st;
    if (t0) (void)xb_add(&bar[XB_XCNT(b.x)], 1u);
    return b;
}
__device__ __forceinline__ void xcd_barrier_complete(unsigned* bar, unsigned x, unsigned& nloc, unsigned& nx) {
    const unsigned G = gridDim.x * gridDim.y * gridDim.z;
    unsigned sum, cnt, mine, sp = 0u;
    for (;;) {
        sum = 0u; cnt = 0u; mine = 0u;
#pragma unroll
        for (unsigned j = 0; j < 16; ++j) { const unsigned c = xb_ld(&bar[XB_XCNT(j)]); sum += c; cnt += (c > 0u) ? 1u : 0u; mine = (j == x) ? c : mine; }
        if (sum == G) break;
        __builtin_amdgcn_s_sleep(1);
        if ((++sp & 255u) == 0u) { if (xb_ld(&bar[XB_TMO])) break; if (sp > XB_SPIN_CAP) { atomicAdd(&bar[XB_TMO], 1u); break; } }
    }
    nloc = mine > 0u ? mine : 1u; nx = cnt > 0u ? cnt : 1u;
}
__device__ __forceinline__ void xcd_barrier(const XcdBarrier& b, const bool t0) {
    asm volatile("s_waitcnt vmcnt(0)" ::: "memory");
    __syncthreads();
    if (t0) {
        unsigned* bar = b.bar;
        __builtin_amdgcn_s_waitcnt(0);
        unsigned nloc = b.st[0], nx = b.st[1];
        if (nloc == 0u) { xcd_barrier_complete(bar, b.x, nloc, nx); b.st[0] = nloc; b.st[1] = nx; }
        const unsigned old = xb_add(&bar[XB_XSUB(b.x)], 1u);
        const unsigned gen = old / nloc;
        if (old + 1u == (gen + 1u) * nloc) {
            __builtin_amdgcn_fence(__ATOMIC_RELEASE, "agent");
            asm volatile("s_waitcnt vmcnt(0)" ::: "memory");
            const unsigned og = xb_add(&bar[XB_TOP], 1u);
            const unsigned tg = og / nx;
            if (og + 1u == (tg + 1u) * nx) xb_add(&bar[XB_TOPGEN], 1u);
            else XB_SPIN(xb_ld(&bar[XB_TOPGEN]) == tg, bar);
            __builtin_amdgcn_fence(__ATOMIC_ACQUIRE, "agent");
            xb_add(&bar[XB_XGEN(b.x)], 1u);
            asm volatile("s_waitcnt vmcnt(0)" ::: "memory");
        } else {
            XB_SPIN(xb_ld(&bar[XB_XGEN(b.x)]) == gen, bar);
            __builtin_amdgcn_fence(__ATOMIC_ACQUIRE, "agent");
            asm volatile("s_waitcnt vmcnt(0)" ::: "memory");
        }
    }
    __syncthreads();
}

#define NORM_ROWS(body) do { \
    if (ngw == 2048 && slab) { \
        if (gw < SLAB_ROWS) { { const int row = SLAB_ROW0 + gw; body } for (int row = gw; row < 5 * SLAB_ROWS; row += SLAB_ROWS) { body } } \
        else for (int row = 5 * SLAB_ROWS + (gw - SLAB_ROWS); row < SLAB_ROW0; row += 2048 - SLAB_ROWS) { body } \
    } else for (int row = gw; row < MROWS; row += ngw) { body } } while (0)
__device__ __forceinline__ void norm_rows_bf16(float* h, const float* gain, bf16_t* xn, const float* slab, int gw, int ngw) {
    const int lane = lane_id_opaque();
    f32x4 gv[8];
#pragma unroll
    for (int j = 0; j < 8; ++j) gv[j] = ((const f32x4*)gain)[lane + 64 * j];
    NORM_ROWS({
        u32x2* xr = (u32x2*)((bf16_t*)h + (size_t)row * DM) + lane; f32x4 v[8]; float s = 0.f;
        _Pragma("unroll") for (int j = 0; j < 8; ++j) { const u32x2 hw = xr[64 * j]; v[j][0] = __uint_as_float(hw.x << 16); v[j][1] = __uint_as_float(hw.x & 0xffff0000u); v[j][2] = __uint_as_float(hw.y << 16); v[j][3] = __uint_as_float(hw.y & 0xffff0000u); }
        if (slab && row >= SLAB_ROW0) {
            _Pragma("unroll") for (int p = 0; p < NSLAB; ++p) { const u32x2* sr = (const u32x2*)((const bf16_t*)slab + ((size_t)p * SLAB_ROWS + (row - SLAB_ROW0)) * DM) + lane;
                _Pragma("unroll") for (int j = 0; j < 8; ++j) { const u32x2 w = sr[64 * j]; v[j][0] += __uint_as_float(w.x << 16); v[j][1] += __uint_as_float(w.x & 0xffff0000u); v[j][2] += __uint_as_float(w.y << 16); v[j][3] += __uint_as_float(w.y & 0xffff0000u); } }
            _Pragma("unroll") for (int j = 0; j < 8; ++j) { u32x2 hw; hw.x = cvt_pk_bf16(v[j][0], v[j][1]); hw.y = cvt_pk_bf16(v[j][2], v[j][3]); xr[64 * j] = hw; }
        }
        _Pragma("unroll") for (int j = 0; j < 8; ++j) s += (v[j][0] * v[j][0] + v[j][1] * v[j][1]) + (v[j][2] * v[j][2] + v[j][3] * v[j][3]);
        const float rs = 1.0f / sqrtf(wave_sum(s) * (1.0f / DM) + EPS);
        u32x2* o = (u32x2*)(xn + (size_t)row * DM) + lane;
        _Pragma("unroll") for (int j = 0; j < 8; ++j) { const f32x4 y = v[j] * rs * gv[j]; u32x2 w; w.x = cvt_pk_bf16(y[0], y[1]); w.y = cvt_pk_bf16(y[2], y[3]); o[64 * j] = w; }
    });
}
__device__ __forceinline__ void norm_rows_out(const float* h, const float* gain, float* out, const float* slab, int gw, int ngw) {
    const int lane = lane_id_opaque();
    f32x4 gv[8];
#pragma unroll
    for (int j = 0; j < 8; ++j) gv[j] = ((const f32x4*)gain)[lane + 64 * j];
    NORM_ROWS({
        if (!(row >= ROW_PAD && row < ROW_P0 + NMETA)) {
        float* dst = row < ROW_PAD ? out + O_YS + (size_t)row * DM : out + O_YP + (size_t)(row - ROW_P0 - NMETA) * DM;
        const u32x2* xr = (const u32x2*)((const bf16_t*)h + (size_t)row * DM) + lane; f32x4 v[8]; float s = 0.f;
        _Pragma("unroll") for (int j = 0; j < 8; ++j) { const u32x2 hw = xr[64 * j]; v[j][0] = __uint_as_float(hw.x << 16); v[j][1] = __uint_as_float(hw.x & 0xffff0000u); v[j][2] = __uint_as_float(hw.y << 16); v[j][3] = __uint_as_float(hw.y & 0xffff0000u); }
        if (row >= SLAB_ROW0) {
            _Pragma("unroll") for (int p = 0; p < NSLAB; ++p) { const u32x2* sr = (const u32x2*)((const bf16_t*)slab + ((size_t)p * SLAB_ROWS + (row - SLAB_ROW0)) * DM) + lane;
                _Pragma("unroll") for (int j = 0; j < 8; ++j) { const u32x2 w = sr[64 * j]; v[j][0] += __uint_as_float(w.x << 16); v[j][1] += __uint_as_float(w.x & 0xffff0000u); v[j][2] += __uint_as_float(w.y << 16); v[j][3] += __uint_as_float(w.y & 0xffff0000u); } }
        }
        _Pragma("unroll") for (int j = 0; j < 8; ++j) s += (v[j][0] * v[j][0] + v[j][1] * v[j][1]) + (v[j][2] * v[j][2] + v[j][3] * v[j][3]);
        const float rs = 1.0f / sqrtf(wave_sum(s) * (1.0f / DM) + EPS);
        _Pragma("unroll") for (int j = 0; j < 8; ++j) ((f32x4*)dst)[lane + 64 * j] = v[j] * rs * gv[j];
        }
    });
}
__device__ __forceinline__ void transpose_item(const float* W, int ldw, int nblk, bf16_t* WT, int ldt, LAS float* scr, int item, int lane) {
    const int kb = item / nblk, nb = item % nblk, k0 = 64 * kb, n0 = 32 * nb;
    f32x4 t[8];
#pragma unroll
    for (int i = 0; i < 8; ++i) t[i] = *(const f32x4*)(W + (size_t)(k0 + 8 * i + (lane >> 3)) * ldw + n0 + 4 * (lane & 7));
#pragma unroll
    for (int i = 0; i < 8; ++i) { LAS float* d = scr + (8 * i + (lane >> 3)) * 33 + 4 * (lane & 7); d[0] = t[i][0]; d[1] = t[i][1]; d[2] = t[i][2]; d[3] = t[i][3]; }
    LDS_WAIT(); asm volatile("" ::: "memory");
    const int c = lane & 7;
#pragma unroll
    for (int j = 0; j < 4; ++j) { const int n = (lane >> 3) + 8 * j; const LAS float* s = scr + (8 * c) * 33 + n;
        u32x4 o; o.x = cvt_pk_bf16(s[0 * 33], s[1 * 33]); o.y = cvt_pk_bf16(s[2 * 33], s[3 * 33]); o.z = cvt_pk_bf16(s[4 * 33], s[5 * 33]); o.w = cvt_pk_bf16(s[6 * 33], s[7 * 33]);
        *(u32x4*)(WT + (size_t)(n0 + n) * ldt + k0 + 8 * c) = o; }
    LDS_WAIT(); asm volatile("" ::: "memory");
}
__device__ __forceinline__ void sincos_d(double a, float& sv, float& cv) {
    const double n = __builtin_rint(a * 0.63661977236758134308);
    double r = __builtin_fma(-n, 1.57079632679489655800e+00, a); r = __builtin_fma(-n, 6.12323399573676603587e-17, r);
    const double z = r * r;
    const double sp = r * (1.0 + z * (-1.0 / 6 + z * (1.0 / 120 + z * (-1.0 / 5040 + z * (1.0 / 362880 + z * (-1.0 / 39916800 + z * (1.0 / 6227020800.0)))))));
    const double cp = 1.0 + z * (-0.5 + z * (1.0 / 24 + z * (-1.0 / 720 + z * (1.0 / 40320 + z * (-1.0 / 3628800 + z * (1.0 / 479001600 + z * (-1.0 / 87178291200.0)))))));
    const int q = ((int)(long long)n) & 3;
    const double s = (q & 1) ? cp : sp, c = (q & 1) ? sp : cp;
    sv = (float)((q & 2) ? -s : s); cv = (float)(((q + 1) & 2) ? -c : c);
}
__device__ __forceinline__ void prologue_phase(const float* const* in, unsigned char* ws, LAS unsigned char* lds, int gw, int ngw, int wave) {
    const int lane = lane_id_opaque();
    LAS float* scr = (LAS float*)(lds + wave * 16384);
    constexpr int I_FI = 32 * 256, I_FO = 32 * 64, I_RI = 32 * 384, I_RO = 64 * 64, I_UP = 32 * 256, I_DN = 128 * 64;
    constexpr int NITEMS = 2 * I_FI + 2 * I_FO + 2 * I_RI + 2 * I_RO + 4 * I_UP + 4 * I_DN;
    for (int it = gw; it < NITEMS; it += ngw) {
        int r = it;
        if (r < 2 * I_FI) { const int j = r / I_FI; transpose_item(in[10] + (size_t)j * DM * NFOXIN, NFOXIN, 256, (bf16_t*)(ws + WS_WFI + j * SZ_WFI), DM, scr, r % I_FI, lane); continue; } r -= 2 * I_FI;
        if (r < 2 * I_FO) { const int j = r / I_FO; transpose_item(in[14] + (size_t)j * DM * DM, DM, 64, (bf16_t*)(ws + WS_WFO + j * SZ_WFO), DM, scr, r % I_FO, lane); continue; } r -= 2 * I_FO;
        if (r < 2 * I_RI) { const int j = r / I_RI; transpose_item(in[15] + (size_t)j * DM * NRETIN, NRETIN, 384, (bf16_t*)(ws + WS_WRI + j * SZ_WRI), DM, scr, r % I_RI, lane); continue; } r -= 2 * I_RI;
        if (r < 2 * I_RO) { const int j = r / I_RO; transpose_item(in[17] + (size_t)j * DVT * DM, DM, 64, (bf16_t*)(ws + WS_WRO + j * SZ_WRO), DVT, scr, r % I_RO, lane); continue; } r -= 2 * I_RO;
        if (r < 4 * I_UP) { const int l = r / I_UP; transpose_item(in[18] + (size_t)l * DM * DFF, DFF, 256, (bf16_t*)(ws + WS_WUP + l * SZ_WUP), DM, scr, r % I_UP, lane); continue; } r -= 4 * I_UP;
        { const int l = r / I_DN; transpose_item(in[19] + (size_t)l * DFF * DM, DM, 64, (bf16_t*)(ws + WS_WDN + l * SZ_WDN), DFFP, scr, r % I_DN, lane); }
    }
    const int gt = gw * 64 + lane, ngt = ngw * 64;
    for (int e = gt; e < 2 * 16 * DM; e += ngt) { const int j = e / (16 * DM), c = (e / DM) & 15, k = e % DM;
        ((bf16_t*)(ws + WS_WFI + j * SZ_WFI))[(size_t)(8192 + c) * DM + k] = (bf16_t)(cvt_pk_bf16(in[10][(size_t)j * DM * NFOXIN + (size_t)k * NFOXIN + 8192 + c], 0.f) & 0xffffu); }
    for (int e = gt; e < 2 * 240 * DM / 8; e += ngt) { const int j = e / (240 * DM / 8), o = e % (240 * DM / 8);
        ((u32x4*)(ws + WS_WFI + j * SZ_WFI + (size_t)8208 * DM * 2))[o] = (u32x4){0u, 0u, 0u, 0u}; }
    float* h = (float*)(ws + WS_H); bf16_t* xn = (bf16_t*)(ws + WS_XN);
    { f32x4 gv[8];
#pragma unroll
      for (int j = 0; j < 8; ++j) gv[j] = ((const f32x4*)in[7])[lane + 64 * j];
      for (int row = gw; row < MROWS; row += ngw) { u32x2* d = (u32x2*)((bf16_t*)h + (size_t)row * DM) + lane;
        const float* s = row < ROW_PAD ? in[1] + (size_t)row * DM : (row < ROW_P0 ? nullptr : (row < ROW_P0 + NMETA ? in[6] + (size_t)(row - ROW_P0) * DM : in[0] + (size_t)(row - ROW_P0 - NMETA) * DM));
        f32x4 v[8]; float ss = 0.f;
#pragma unroll
        for (int j = 0; j < 8; ++j) { v[j] = s ? ((const f32x4*)s)[lane + 64 * j] : (f32x4){0.f, 0.f, 0.f, 0.f}; { u32x2 hw; hw.x = cvt_pk_bf16(v[j][0], v[j][1]); hw.y = cvt_pk_bf16(v[j][2], v[j][3]); d[64 * j] = hw; }
            ss += (v[j][0] * v[j][0] + v[j][1] * v[j][1]) + (v[j][2] * v[j][2] + v[j][3] * v[j][3]); }
        const float rs = 1.0f / sqrtf(wave_sum(ss) * (1.0f / DM) + EPS);
        u32x2* o = (u32x2*)(xn + (size_t)row * DM) + lane;
#pragma unroll
        for (int j = 0; j < 8; ++j) { const f32x4 y = v[j] * rs * gv[j]; u32x2 w; w.x = cvt_pk_bf16(y[0], y[1]); w.y = cvt_pk_bf16(y[2], y[3]); o[64 * j] = w; } } }
    float* COS = (float*)(ws + WS_COS); float* SIN = (float*)(ws + WS_SIN);
    for (int e = gt; e < LP * 128; e += ngt) { const int pos = e >> 7, c = e & 127;
        const float inv = (float)exp2(-(double)c * (13.287712379549449 / 128.0)); const float ang = (float)pos * inv; float sv, cv; sincos_d((double)ang, sv, cv);
        COS[e] = cv; SIN[e] = sv; }
}
__device__ __forceinline__ void fox_cache_phase(const float* ck, const float* cv, bf16_t* kbuf, bf16_t* vbuf, int gw, int ngw, bool convert) {
    const int lane = lane_id_opaque();
    if (convert) for (int t = gw; t < 2 * DB * PAST; t += ngw) { const int which = t >= DB * PAST, r = which ? t - DB * PAST : t;
        const f32x4* s = (const f32x4*)((which ? cv : ck) + (size_t)r * DM) + lane; u32x2* d = (u32x2*)((which ? vbuf : kbuf) + ((size_t)(r >> 10) * SKS + (r & 1023)) * DM) + lane;
#pragma unroll
        for (int j = 0; j < 8; ++j) { const f32x4 y = s[64 * j]; u32x2 w; w.x = cvt_pk_bf16(y[0], y[1]); w.y = cvt_pk_bf16(y[2], y[3]); d[64 * j] = w; } }
    for (int t = gw; t < 2 * 48; t += ngw) { u32x2* d = (u32x2*)((t >= 48 ? vbuf : kbuf) + (size_t)(KB_ROWS - 48 + (t % 48)) * DM) + lane;
#pragma unroll
        for (int j = 0; j < 8; ++j) d[64 * j] = (u32x2){0u, 0u}; }
}
__device__ __forceinline__ void scan_job(int wg, const float* lf, const float* clf, float* bP, float* bS, LAS double* sums, int wave) {
    const int lane = lane_id_opaque(), tid = wave * 64 + lane;
    constexpr double L2E = 1.4426950408889634;
    if (wg < 16) {
        const int head = wg, p0 = tid * 33; float v[33]; double s = 0.0;
#pragma unroll
        for (int i = 0; i < 33; ++i) { const int p = p0 + i; v[i] = p < LP ? lf[(size_t)(ROW_P0 + p) * HF + head] : 0.f; }
#pragma unroll
        for (int i = 0; i < 33; ++i) s += (double)v[i];
        double inc = s;
#pragma unroll
        for (int o = 1; o < 64; o <<= 1) { const double t = __shfl_up(inc, o); if (lane >= o) inc += t; }
        if (lane == 63) sums[wave] = inc;
        LDS_WAIT(); __syncthreads();
        double run = inc - s;
        for (int w = 0; w < wave; ++w) run += sums[w];
        float* out = bP + (size_t)head * BP_LEN;
#pragma unroll
        for (int i = 0; i < 33; ++i) { const int p = p0 + i; run += (double)v[i]; if (p < LP) out[p] = (float)(-run * L2E); }
        if (tid < BP_LEN - LP) out[LP + tid] = 0.f;
    } else {
        const int b = wg - 16, head = tid & 15, ck = tid >> 4, p0 = ck * 34; float v[34]; double s = 0.0;
#pragma unroll
        for (int i = 0; i < 34; ++i) { const int p = p0 + i; v[i] = p < PAST ? clf[((size_t)b * PAST + p) * HF + head] : lf[(size_t)(b * DS + p - PAST) * HF + head]; }
#pragma unroll
        for (int i = 0; i < 34; ++i) s += (double)v[i];
        sums[ck * 16 + head] = s;
        LDS_WAIT(); __syncthreads();
        double run = 0.0;
        for (int c = 0; c < ck; ++c) run += sums[c * 16 + head];
        float* out = bS + ((size_t)b * HF + head) * SKS;
#pragma unroll
        for (int i = 0; i < 34; ++i) { run += (double)v[i]; out[p0 + i] = (float)(-run * L2E); }
    }
}
__device__ __forceinline__ void scan_phase(const float* lf, const float* clf, float* bP, float* bS, LAS unsigned char* lds, int wave) {
    if ((int)blockIdx.x < 32) scan_job((int)blockIdx.x, lf, clf, bP, bS, (LAS double*)lds, wave);
}
#ifndef FA_CUT_BITS
#define FA_CUT_BITS 68
#endif
constexpr float FA_CUT = (float)FA_CUT_BITS + 2.0f;
__device__ __forceinline__ fa::BlockRef fa_ref(int item, const float* B, float thr, int lane) {
    fa::BlockRef r;
    if (item < 65 * HF) { const int blk = 64 - item / HF, head = item & 15;
        r.qo = (unsigned)((ROW_PAD + 256 * blk) * DM + head * DHF); r.ko = (unsigned)(KB_PROMPT0 * DM + head * DHF); r.bo = (unsigned)(head * BP_LEN);
        r.P0 = -240 + 256 * blk; const int p1 = r.P0 > 0 ? r.P0 : 0; r.bref = B[r.bo + p1]; r.jhi = (r.P0 + 255) / 64 + 1; r.nvw = 8;
        r.jlo = fa::first_tile_above(B + r.bo + 63, r.bref - thr, p1 >> 6, lane); }
    else { const int s = item - 65 * HF, b = s >> 4, head = s & 15;
        r.qo = (unsigned)((b * DS) * DM + head * DHF); r.ko = (unsigned)((b * SKS) * DM + head * DHF); r.bo = (unsigned)(HF * BP_LEN + (b * HF + head) * SKS);
        r.P0 = PAST; r.bref = B[r.bo + PAST]; r.jlo = 0; r.jhi = SKS / 64; r.nvw = 2; }
    return r;
}
__device__ __forceinline__ void attn_phase(unsigned* head_word, const bf16_t* qbuf, const bf16_t* kbuf, const bf16_t* vbuf, const bf16_t* gbuf, bf16_t* obuf, const float* B, const float* gq, const float* gk, char* ldsg, const int wave) {
    constexpr int NITEMS = 65 * HF + DB * HF; const int lane = lane_id_opaque(); const bool t0 = wave == 0 && lane == 0;
    volatile LAS unsigned* qw = (volatile LAS unsigned*)(LAS char*)(ldsg + fa::OFF_Q);

    float gm = fmaxf(fabsf(gq[lane]), fabsf(gq[lane + 64])), km = fmaxf(fabsf(gk[lane]), fabsf(gk[lane + 64]));
#pragma unroll
    for (int o = 1; o < 64; o <<= 1) { gm = fmaxf(gm, __shfl_xor(gm, o)); km = fmaxf(km, __shfl_xor(km, o)); }
    const float qb = 1.4426950408889634f * 11.313708498984761f * 1.02f * gm * km, thr = FA_CUT + 2.0f * qb;
    const fa::Bases BS{qbuf, kbuf, vbuf, gbuf, B, obuf, FA_CUT + qb};
#define FA_FETCH(dst) do { if (t0) qw[0] = __hip_atomic_fetch_add(head_word, 1u, RLX_AGENT); __syncthreads(); dst = __builtin_amdgcn_readfirstlane((int)qw[0]); } while (0)
    int ci; FA_FETCH(ci);
    if (ci < NITEMS) {
        fa::BlockRef cur = fa_ref(ci, B, thr, lane); fa::Seam S;
        fa::attn_prime(BS, cur, ldsg, S, wave);
        for (;;) { int ni; FA_FETCH(ni); const bool last = ni >= NITEMS; const fa::BlockRef nxt = last ? cur : fa_ref(ni, B, thr, lane);
            fa::attn_block(BS, cur, nxt, ldsg, S, wave); if (last) break; cur = nxt; }
    }
#undef FA_FETCH
}
__device__ __forceinline__ void ret_state_phase(const float* S0, bf16_t* BTS, LAS unsigned char* lds, int gw, int ngw, int wave) {
    const int lane = lane_id_opaque();
    LAS float* scr = (LAS float*)(lds + wave * 16384);
    for (int it = gw; it < DB * HR * 64; it += ngw) { const int mtx = it >> 6, b = mtx >> 3, head = mtx & 7, tile = b >> 2, bb = b & 3;
        transpose_item(S0 + (size_t)mtx * DKR * DVR, DVR, 16, BTS + (((size_t)head * 4 + tile) * 512) * 1280 + 256 + 256 * bb, 1280, scr, it & 63, lane); }
}
__device__ __forceinline__ void ret_transpose_phase(const bf16_t* krn, bf16_t* kTp, bf16_t* kTs, LAS unsigned char* lds, int gw, int ngw, int wave) {
    const int lane = lane_id_opaque();
    LAS unsigned char* scr = lds + wave * 16384;
    const int bx = (int)blockIdx.x; const bool bal = (ngw == 2048);
    const int s0 = !bal ? gw : (bx < 40 ? bx * 8 + wave : 320 + ((bx - 40) * 8 + wave) * 2), ns = (bal && bx >= 40) ? 2 : 1, st = bal ? 3776 : ngw;
    for (int kk = 0;; ++kk) { const int it = ns == 2 ? s0 + (kk & 1) + (kk >> 1) * st : s0 + kk * st; if (it >= NTILE * 4 * 32) break;
        const int pm = it >> 7, rg = (it >> 5) & 3, cg = it & 31, row0 = pm * 256 + rg * 64, col0 = cg * 64;
        u32x4 tt[8];
#pragma unroll
        for (int i = 0; i < 8; ++i) tt[i] = *(const u32x4*)(krn + (size_t)(row0 + 8 * i + (lane >> 3)) * DM + col0 + 8 * (lane & 7));
#pragma unroll
        for (int i = 0; i < 8; ++i) { LAS unsigned* d = (LAS unsigned*)(scr + (8 * i + (lane >> 3)) * 132 + 16 * (lane & 7)); d[0] = tt[i][0]; d[1] = tt[i][1]; d[2] = tt[i][2]; d[3] = tt[i][3]; }
        LDS_WAIT(); asm volatile("" ::: "memory");
#pragma unroll 8
        for (int i = 0; i < 32; ++i) { const int d = 2 * i + (lane >> 5), t2 = (lane & 31) * 2;
            const unsigned lo = *(const LAS unsigned short*)(scr + t2 * 132 + d * 2), hi = *(const LAS unsigned short*)(scr + (t2 + 1) * 132 + d * 2); const unsigned w = lo | (hi << 16);
            if (pm >= 4) *(unsigned*)(kTp + (size_t)(col0 + d) * MROWS + row0 + t2) = w;
            else { const int head = cg >> 2, dk = (cg & 3) * 64 + d;
#pragma unroll
                for (int bb = 0; bb < 4; ++bb) *(unsigned*)(kTs + ((((size_t)head * 4 + pm) * 4 + bb) * 256 + dk) * 256 + rg * 64 + t2) = bb == rg ? w : 0u; } }
        LDS_WAIT(); asm volatile("" ::: "memory");
    }
}
__device__ __forceinline__ void ret_prefix_phase(bf16_t* BT, float* out_state, int gw, int ngw) {
    const int gt = gw * 64 + lane_id_opaque(), ngt = ngw * 64;
    for (int e = gt; e < HR * 512 * 32; e += ngt) { const int head = e >> 14, dv = (e >> 5) & 511, dk8 = (e & 31) * 8;
        const float g256 = __builtin_amdgcn_exp2f(ret_lg2gamma(head) * 256.0f); float s[8];
#pragma unroll
        for (int k = 0; k < 8; ++k) s[k] = 0.f;
        bf16_t* p = BT + (((size_t)head * 65) * 512 + dv) * 512 + 256 + dk8;
        for (int b0 = 0; b0 < 65; b0 += 13) { u32x4 uu[13];
#pragma unroll
            for (int b = 0; b < 13; ++b) uu[b] = *(const u32x4*)(p + (size_t)(b0 + b) * 512 * 512);
#pragma unroll
            for (int b = 0; b < 13; ++b) { const u32x4 u = uu[b];
                u32x4 w; w.x = cvt_pk_bf16(s[0], s[1]); w.y = cvt_pk_bf16(s[2], s[3]); w.z = cvt_pk_bf16(s[4], s[5]); w.w = cvt_pk_bf16(s[6], s[7]); *(u32x4*)(p + (size_t)(b0 + b) * 512 * 512) = w;
#pragma unroll
                for (int k = 0; k < 4; ++k) { s[2 * k] = s[2 * k] * g256 + __uint_as_float(u[k] << 16); s[2 * k + 1] = s[2 * k + 1] * g256 + __uint_as_float(u[k] & 0xffff0000u); } } }
#pragma unroll
        for (int k = 0; k < 8; ++k) out_state[((size_t)head * DKR + dk8 + k) * DVR + dv] = s[k]; }
}
constexpr int N_PHASES = 37;
struct Args { const float* in[20]; float* out; unsigned char* ws; int ph_lo, ph_hi; };
__global__ void __launch_bounds__(512, 2) fwd_kernel(Args args) {
    extern __shared__ __attribute__((aligned(16))) unsigned char shm[];
    LAS unsigned char* lds = (LAS unsigned char*)shm;
    const int wave = __builtin_amdgcn_readfirstlane((int)threadIdx.x >> 6);
    unsigned char* const ws0 = args.ws; const float* const* const in0 = args.in; float* const out0 = args.out;
    unsigned* ctl = (unsigned*)(ws0 + WS_CTL);
#define LAUNDER() int lz_; asm volatile("s_mov_b32 %0, 0" : "=s"(lz_)); unsigned char* const ws = ws0 + lz_; const float* const* const in = in0 + lz_; float* const out = out0 + lz_; \
    const int G = (int)gridDim.x + lz_, bx = (int)blockIdx.x, vcu = (G % 8 == 0) ? (bx % 8) * (G / 8) + bx / 8 : bx, gw = vcu * 8 + wave, ngw = G * 8; (void)gw; (void)ngw; (void)in; (void)out
    for (int u = (int)threadIdx.x; u < (LDS_BYTES - MISC_OFF) / 4; u += 512) ((LAS unsigned*)(lds + MISC_OFF))[u] = 0u;
    __syncthreads();
    const bool fold_scan = ((int)gridDim.x == 256);
    const int lo = args.ph_lo, hi = args.ph_hi - ((fold_scan && args.ph_hi == N_PHASES) ? 2 : 0);
    XcdBarrier bar; bar.bar = ctl + CW_BAR; bar.x = 0; bar.st = (volatile LAS unsigned*)(lds + MISC_OFF);
    if (hi - lo > 1) bar = xcd_barrier_post(ctl + CW_BAR, (volatile LAS unsigned*)(lds + MISC_OFF), threadIdx.x == 0);
    int ph = 0;
#define PH_ON (lo <= ph && ph < hi)
#define HP ((float*)(ws + WS_H))
#define XNP ((bf16_t*)(ws + WS_XN))
#define SLABP ((float*)(ws + WS_SLAB))
#define PH_END do { if (lo <= ph && ph + 1 < hi) xcd_barrier(bar, wave == 0 && lane_id_opaque() == 0); ++ph; } while (0)

    if (PH_ON) { LAUNDER(); prologue_phase(in, ws, lds, gw, ngw, wave);
        fox_cache_phase(in[2], in[3], (bf16_t*)(ws + R_K), (bf16_t*)(ws + R_V), gw, ngw, G != 256);
    }
    PH_END;
    for (int i = 0; i < 4; ++i) {
        const int j = i >> 1;
        if ((i & 1) == 0) {
#define qbuf ((bf16_t*)(ws + R_Q))
#define kbuf ((bf16_t*)(ws + R_K))
#define vbuf ((bf16_t*)(ws + R_V))
#define gbuf ((bf16_t*)(ws + R_G))
#define lf ((float*)(ws + WS_LF))
#define bP ((float*)(ws + WS_BP))
#define bS ((float*)(ws + WS_BS))
            if (i > 0) {
            if (PH_ON) { LAUNDER(); norm_rows_bf16(HP, in[7] + (size_t)i * DM, XNP, SLABP, gw, ngw);
                fox_cache_phase(in[2] + (size_t)j * DB * PAST * DM, in[3] + (size_t)j * DB * PAST * DM, kbuf, vbuf, gw, ngw, G != 256); }
            PH_END;
            }
            if (PH_ON) { LAUNDER(); pg8::SchedFoxIn S{(const char*)XNP, (const char*)(ws + WS_WFI + j * SZ_WFI), G, bx};
                pg8::EpiFoxIn E{qbuf, kbuf, vbuf, gbuf, lf, in[11] + j * DHF, in[12] + j * DHF, in[13] + j * HF,
                                out + O_FKP + (size_t)j * LP * DM, out + O_FVP + (size_t)j * LP * DM, out + O_FLP + (size_t)j * LP * HF,
                                out + O_FKS + (size_t)j * DB * DS * DM, out + O_FVS + (size_t)j * DB * DS * DM, out + O_FLS + (size_t)j * DB * DS * HF, (LAS float*)(lds + XL_OFF), G == 256 ? in[2] + (size_t)j * DB * PAST * DM : nullptr, in[3] + (size_t)j * DB * PAST * DM,
                                fold_scan ? (unsigned*)(ws + WS_CTL) + CW_SCAN + 64 * j : nullptr, in[4] + (size_t)j * DB * PAST * HF, bP, bS};
                pg8::gemm_phase(lds, pg8::Shape{DM, DM}, S, E, wave);
                }
            PH_END;
            if (!fold_scan) {
            if (PH_ON) { LAUNDER(); scan_phase(lf, in[4] + (size_t)j * DB * PAST * HF, bP, bS, lds, wave); }
            PH_END;
            }
            if (PH_ON) { LAUNDER(); attn_phase((unsigned*)(ws + WS_CTL) + CW_ATTN + 64 * j, qbuf, kbuf, vbuf, gbuf, XNP, bP, in[11] + j * DHF, in[12] + j * DHF, (char*)shm, wave);
                }
            PH_END;
            if (PH_ON) { LAUNDER(); pg8::SchedResid S{(const char*)XNP, (const char*)(ws + WS_WFO + j * SZ_WFO), G, bx, (size_t)256 * DM * 2, (size_t)256 * DM * 2, DM / 64};
                pg8::EpiResid E{HP, SLABP}; pg8::gemm_phase(lds, pg8::Shape{DM, DM}, S, E, wave); }
            PH_END;
        } else {
#define sg ((bf16_t*)(ws + R_SG))
#define AP ((bf16_t*)(ws + R_AP))
#define BT ((bf16_t*)(ws + R_BT))
#define krn ((bf16_t*)(ws + R_KRN))
#define kTp ((bf16_t*)(ws + R_KTP))
#define ob ((bf16_t*)(ws + R_OB))
#define APS ((bf16_t*)(ws + R_APS))
#define BTS ((bf16_t*)(ws + R_BTS))
#define kTs ((bf16_t*)(ws + R_KTS))
            if (PH_ON) { LAUNDER(); norm_rows_bf16(HP, in[7] + (size_t)i * DM, XNP, i > 0 ? SLABP : nullptr, gw, ngw);
                if (G != 256) ret_state_phase(in[5] + (size_t)j * DB * HR * DKR * DVR, BTS, lds, gw, ngw, wave); }
            PH_END;
            if (PH_ON) { LAUNDER(); pg8::SchedRetIn S{(const char*)XNP, (const char*)(ws + WS_WRI + j * SZ_WRI), G, bx};
                pg8::EpiRetIn E{AP, APS, krn, sg, BT, BTS, (const float*)(ws + WS_COS), (const float*)(ws + WS_SIN)};
                pg8::gemm_phase(lds, pg8::Shape{DM, DM}, S, E, wave);
                }
            PH_END;
            if (PH_ON) { LAUNDER(); ret_transpose_phase(krn, kTp, kTs, lds, gw, ngw, wave); __syncthreads();
                pg8::SchedG1 S{(const char*)AP, (const char*)krn, G, bx}; pg8::EpiG1 E{AP, APS};
                pg8::gemm_phase(lds, pg8::Shape{512, DM}, S, E, wave);
                }
            PH_END;
            if (PH_ON) { LAUNDER(); { pg8::SchedG2p S{(const char*)BT, (const char*)kTp, G, bx}; pg8::EpiG2p E{BT}; pg8::gemm_phase(lds, pg8::Shape{512, MROWS}, S, E, wave); }
                }
            PH_END;
            if (PH_ON) { LAUNDER(); ret_prefix_phase(BT, out + O_RSP + (size_t)j * HR * DKR * DVR, gw, ngw); }
            PH_END;
            if (PH_ON) { LAUNDER(); { pg8::SchedG3p S{(const char*)AP, (const char*)BT, G, bx}; pg8::EpiG3 E{ob, sg, in[16] + (size_t)j * HR * DVR, (LAS float*)(lds + XL_OFF), (LAS float*)(lds + XL_OFF + 4096)}; pg8::gemm_phase(lds, pg8::Shape{512, 512}, S, E, wave); }
                { pg8::SchedG3s S{(const char*)APS, (const char*)BTS, G, bx}; pg8::EpiG3 E{ob, sg, in[16] + (size_t)j * HR * DVR, (LAS float*)(lds + XL_OFF), (LAS float*)(lds + XL_OFF + 4096)}; pg8::gemm_phase(lds, pg8::Shape{1280, 1280}, S, E, wave); }
                { const bool pool = (G == 256); const int Gs = pool ? 184 : G, cs = pool ? bx - 40 : bx;
                  if (cs >= 0 && cs < Gs) { pg8::SchedG2s S{(const char*)kTs, (const char*)BTS, Gs, cs}; pg8::EpiG2s E{in[5] + (size_t)j * DB * HR * DKR * DVR, out + O_RSS + (size_t)j * DB * HR * DKR * DVR};
                      pg8::gemm_phase(lds, pg8::Shape{256, 1280}, S, E, wave); } }
                }
            PH_END;
            if (PH_ON) { LAUNDER(); pg8::SchedResid S{(const char*)ob, (const char*)(ws + WS_WRO + j * SZ_WRO), G, bx, (size_t)256 * DVT * 2, (size_t)256 * DVT * 2, DVT / 64};
                pg8::EpiResid E{HP, SLABP}; pg8::gemm_phase(lds, pg8::Shape{DVT, DVT}, S, E, wave); }
            PH_END;
        }
#define ub ((bf16_t*)(ws + R_U))
        if (PH_ON) { LAUNDER(); norm_rows_bf16(HP, in[8] + (size_t)i * DM, XNP, SLABP, gw, ngw);
            }
        PH_END;
        if (PH_ON) { LAUNDER(); pg8::SchedSimple S{(const char*)XNP, (const char*)(ws + WS_WUP + i * SZ_WUP), NTILE, 32, G, bx, (size_t)256 * DM * 2, (size_t)256 * DM * 2, DM / 64};
            pg8::EpiUp E{ub}; pg8::gemm_phase(lds, pg8::Shape{DM, DM}, S, E, wave);
            if ((i & 1) == 0 && G == 256 && bx >= 160) ret_state_phase(in[5] + (size_t)(i >> 1) * DB * HR * DKR * DVR, (bf16_t*)(ws + R_BTS), lds, (bx - 160) * 8 + wave, 96 * 8, wave);
            }
        PH_END;
        if (PH_ON) { LAUNDER(); pg8::SchedResid S{(const char*)ub, (const char*)(ws + WS_WDN + i * SZ_WDN), G, bx, (size_t)256 * DFFP * 2, (size_t)256 * DFFP * 2, DFF / 64};
            pg8::EpiResid E{HP, SLABP}; pg8::gemm_phase(lds, pg8::Shape{DFFP, DFFP}, S, E, wave);
            }
        PH_END;
    }
    if (PH_ON) { LAUNDER(); norm_rows_out(HP, in[9], out, SLABP, gw, ngw); }
#undef PH_ON
#undef qbuf
#undef kbuf
#undef vbuf
#undef gbuf
#undef lf
#undef bP
#undef bS
#undef sg
#undef AP
#undef BT
#undef krn
#undef kTp
#undef ob
#undef APS
#undef BTS
#undef kTs
#undef ub
#undef HP
#undef XNP
#undef SLABP
#undef LAUNDER
#undef PH_END
}

#ifndef MK_PER_PHASE
#define MK_PER_PHASE 0
#endif
extern "C" void kernel_launch(void* const* d_in, const int* in_sizes, int n_in, void* d_out, int out_size, void* d_ws, size_t ws_size, hipStream_t stream) {
    static int grid = 0;
    if (grid == 0) {
        if (n_in != 20 || (size_t)out_size != O_END || ws_size < WS_END) { fprintf(stderr, "kernel_launch: unexpected shapes (n_in %d, out %d, ws %zu; need ws >= %zu)\n", n_in, out_size, ws_size, (size_t)WS_END); grid = -1; return; }
        int dev = 0, cus = 0, per_cu = 0;
        if (hipGetDevice(&dev) != hipSuccess || hipDeviceGetAttribute(&cus, hipDeviceAttributeMultiprocessorCount, dev) != hipSuccess) { grid = -1; return; }
        if (hipFuncSetAttribute((const void*)fwd_kernel, hipFuncAttributeMaxDynamicSharedMemorySize, LDS_BYTES) != hipSuccess) { fprintf(stderr, "kernel_launch: hipFuncSetAttribute failed\n"); grid = -1; return; }
        if (hipOccupancyMaxActiveBlocksPerMultiprocessor(&per_cu, (const void*)fwd_kernel, 512, LDS_BYTES) != hipSuccess || per_cu < 1) fprintf(stderr, "kernel_launch: occupancy query reports %d\n", per_cu);
        (void)hipGetLastError();
        grid = cus;
    }
    if (grid < 0) return;
    if (hipMemsetAsync((char*)d_ws + WS_CTL, 0, CTL_ZERO_BYTES, stream) != hipSuccess) return;
    Args a{};
    for (int i = 0; i < 20; ++i) a.in[i] = (const float*)d_in[i];
    a.out = (float*)d_out; a.ws = (unsigned char*)d_ws;
#if MK_PER_PHASE
    for (int p = 0; p < N_PHASES; ++p) { a.ph_lo = p; a.ph_hi = p + 1; hipLaunchKernelGGL(fwd_kernel, dim3(grid), dim3(512), LDS_BYTES, stream, a); }
#else
    a.ph_lo = 0; a.ph_hi = N_PHASES;
    hipLaunchKernelGGL(fwd_kernel, dim3(grid), dim3(512), LDS_BYTES, stream, a);
#endif
}
```
